# Optimizing an MI355X kernel written in HIP

```python
import math
import jax, jax.numpy as jnp
from jax import lax
import numpy as np

D_MODEL = 1024
BATCH = 32
SEQ = 256
DEPTH = 2
DEC_BATCH = 2
DEC_SEQ = 2048
PAST_LEN = 512

GRID_W = 64
HEAD_DIM = 64
POOL_WIDTH = D_MODEL // 4
POOL_GROUPS = 4
POOL_GROUP_W = POOL_WIDTH // POOL_GROUPS
POOL_WINDOWS = (2, 4, 8, 16)
DIFF_HEADS = (D_MODEL // 2) // (2 * HEAD_DIM)
DIFF_QK_W = DIFF_HEADS * 2 * HEAD_DIM
DIFF_V_W = DIFF_HEADS * 2 * HEAD_DIM
NA_HEADS = (D_MODEL // 4) // HEAD_DIM
NA_W = NA_HEADS * HEAD_DIM
NA_ROWS = 8
NA_COLS = 16
N_BRANCH = 3
SPLIT_SIZES = (POOL_WIDTH, DIFF_QK_W, DIFF_QK_W, DIFF_V_W, NA_W, NA_W, NA_W, N_BRANCH * D_MODEL)
D_IN = POOL_WIDTH + 2 * DIFF_QK_W + DIFF_V_W + 3 * NA_W + N_BRANCH * D_MODEL
D_FF = ((8 * D_MODEL // 3 + 127) // 128) * 128
N_MOD = 9
QB = 128
ROPE_BASE = 10000.0
LN_EPS = 1e-5
RMS_EPS = 1e-5
ALPHA = (2 * DEPTH) ** 0.25
BETA = (8 * DEPTH) ** -0.25
ATTN_SCALE = HEAD_DIM ** -0.5
NEG_INF = -1e30

kernel_name = "hybrid_diffusion_pool_diffattn_natten_step"


def layer_norm(x, g, b):
    x32 = x.astype(jnp.float32)
    mu = jnp.mean(x32, axis=-1, keepdims=True)
    var = jnp.mean(jnp.square(x32 - mu), axis=-1, keepdims=True)
    return ((x32 - mu) * lax.rsqrt(var + LN_EPS) * g + b).astype(x.dtype)


def swiglu(h, w1, w3, w2):
    return (jax.nn.silu(h @ w1) * (h @ w3)) @ w2


def split_in(z):
    outs = []
    o = 0
    for s in SPLIT_SIZES:
        outs.append(z[..., o:o + s])
        o += s
    return outs


def rope2d(x):
    n = x.shape[1]
    t = jnp.arange(n)
    row = (t // GRID_W).astype(jnp.float32)
    col = (t % GRID_W).astype(jnp.float32)
    nf = HEAD_DIM // 4
    inv = ROPE_BASE ** (-jnp.arange(nf, dtype=jnp.float32) / nf)

    def rot(xh, pos):
        ang = (pos[:, None] * inv)[:, None, None, :]
        cos, sin = jnp.cos(ang), jnp.sin(ang)
        x1, x2 = xh[..., :nf], xh[..., nf:]
        return jnp.concatenate([x1 * cos - x2 * sin, x1 * sin + x2 * cos], axis=-1)

    x32 = x.astype(jnp.float32)
    out = jnp.concatenate([rot(x32[..., :HEAD_DIM // 2], row), rot(x32[..., HEAD_DIM // 2:], col)], axis=-1)
    return out.astype(x.dtype)


def multiscale_pool(a, w_pool, scale):
    n = a.shape[-2]
    af = a.astype(jnp.float32)
    cs = jnp.concatenate([jnp.zeros_like(af[..., :1, :]), jnp.cumsum(af, axis=-2)], axis=-2)
    t = jnp.arange(n)
    outs = []
    for g, w in enumerate(POOL_WINDOWS):
        lo = jnp.clip(t - w // 2, 0, n)
        hi = jnp.clip(t + w // 2, 0, n)
        seg = cs[..., g * POOL_GROUP_W:(g + 1) * POOL_GROUP_W]
        mean = (jnp.take(seg, hi, axis=-2) - jnp.take(seg, lo, axis=-2)) / (hi - lo).astype(jnp.float32)[:, None]
        outs.append(mean - af[..., g * POOL_GROUP_W:(g + 1) * POOL_GROUP_W])
    p = jnp.stack(outs, axis=-2)
    y = jnp.einsum('...ngc,gcd->...ngd', p, w_pool)
    y = y.reshape(*y.shape[:-2], POOL_WIDTH) * scale
    return y.astype(a.dtype)


def diff_attention(q, k, v, lam, lam_init, g):
    b, n = q.shape[:2]
    qb = q.reshape(b, n // QB, QB, *q.shape[2:]).swapaxes(0, 1)

    def one_block(qblk):
        s = jnp.einsum('bqhmd,bkhmd->bhmqk', qblk, k).astype(jnp.float32) * ATTN_SCALE
        p = jax.nn.softmax(s, axis=-1)
        a = (p[:, :, 0] - lam * p[:, :, 1]).astype(v.dtype)
        return jnp.einsum('bhqk,bkhe->bqhe', a, v)

    o = lax.map(one_block, qb).swapaxes(0, 1).reshape(b, n, *v.shape[2:])
    o32 = o.astype(jnp.float32)
    o32 = o32 * lax.rsqrt(jnp.mean(jnp.square(o32), axis=-1, keepdims=True) + RMS_EPS) * g * (1.0 - lam_init)
    return o32.astype(v.dtype).reshape(b, n, -1)


def dense_attention(q, k, v):
    b, n, h, hd = q.shape
    qb = q.reshape(b, n // QB, QB, h, hd).swapaxes(0, 1)

    def one_block(qblk):
        s = jnp.einsum('bqhd,bkhd->bhqk', qblk, k).astype(jnp.float32) * ATTN_SCALE
        p = jax.nn.softmax(s, axis=-1).astype(v.dtype)
        return jnp.einsum('bhqk,bkhd->bqhd', p, v)

    return lax.map(one_block, qb).swapaxes(0, 1).reshape(b, n, h * hd)


def neighbourhood_attention(q, k, v, ck, cv, rpb):
    b, l, h, hd = q.shape
    rows = l // GRID_W
    kh = min(NA_ROWS, rows)
    qg = q.reshape(b, rows, GRID_W, h, hd)
    kg = k.reshape(b, rows, GRID_W, h, hd)
    vg = v.reshape(b, rows, GRID_W, h, hd)
    r = jnp.arange(rows)
    row_start = jnp.clip(r - kh // 2, 0, rows - kh)
    row_idx = row_start[:, None] + jnp.arange(kh)
    k_nb = kg[:, row_idx]
    v_nb = vg[:, row_idx]
    col = jnp.arange(GRID_W)
    col_start = jnp.clip(col - NA_COLS // 2, 0, GRID_W - NA_COLS)
    col_ok = (col[None, :] >= col_start[:, None]) & (col[None, :] < col_start[:, None] + NA_COLS)
    dr = row_idx - r[:, None] + (NA_ROWS - 1)
    dc = jnp.clip(col[None, :] - col[:, None], -(NA_COLS - 1), NA_COLS - 1) + (NA_COLS - 1)
    bias = rpb[:, dr][:, :, :, dc]
    bias = bias.transpose(0, 1, 3, 2, 4).astype(jnp.float32)
    s_nb = jnp.einsum('brwhd,brkvhd->bhrwkv', qg, k_nb).astype(jnp.float32) * ATTN_SCALE + bias[None]
    s_nb = jnp.where(col_ok[:, None, :], s_nb, NEG_INF)
    s_ctx = jnp.einsum('brwhd,bchd->bhrwc', qg, ck).astype(jnp.float32) * ATTN_SCALE
    s = jnp.concatenate([s_nb.reshape(b, h, rows, GRID_W, kh * GRID_W), s_ctx], axis=-1)
    p = jax.nn.softmax(s, axis=-1).astype(v.dtype)
    p_nb = p[..., :kh * GRID_W].reshape(b, h, rows, GRID_W, kh, GRID_W)
    p_ctx = p[..., kh * GRID_W:]
    o = jnp.einsum('bhrwkv,brkvhd->brwhd', p_nb, v_nb) + jnp.einsum('bhrwc,bchd->brwhd', p_ctx, cv)
    return o.reshape(b, l, h * hd)


def setup_inputs(seed: int = 0) -> dict:
    key = jax.random.key(seed)
    ks = jax.random.split(key, 32)
    f32 = jnp.float32

    def nrm(k, shape, scale=1.0):
        return jax.random.normal(k, shape, f32) * scale

    return {
        'x_prompt': nrm(ks[0], (BATCH, SEQ, D_MODEL)),
        'x_sample': nrm(ks[1], (DEC_BATCH, DEC_SEQ, D_MODEL)),
        'cache_diff_k': nrm(ks[2], (DEC_BATCH, DEPTH, PAST_LEN, DIFF_HEADS, 2, HEAD_DIM)),
        'cache_diff_v': nrm(ks[3], (DEC_BATCH, DEPTH, PAST_LEN, DIFF_HEADS, 2 * HEAD_DIM)),
        'cache_na_k': nrm(ks[4], (DEC_BATCH, DEPTH, PAST_LEN, NA_HEADS, HEAD_DIM)),
        'cache_na_v': nrm(ks[5], (DEC_BATCH, DEPTH, PAST_LEN, NA_HEADS, HEAD_DIM)),
        'c': nrm(ks[6], (DEC_BATCH, D_MODEL)),
        'c_ctx': nrm(ks[7], (D_MODEL,)),
        'w_mod': nrm(ks[8], (DEPTH, D_MODEL, N_MOD * D_MODEL), D_MODEL ** -0.5),
        'b_mod': nrm(ks[9], (DEPTH, N_MOD * D_MODEL), 0.02),
        'ln_g': 1.0 + nrm(ks[10], (DEPTH, 3, D_MODEL), 0.02),
        'ln_b': nrm(ks[11], (DEPTH, 3, D_MODEL), 0.02),
        'ffn1_w1': nrm(ks[12], (DEPTH, D_MODEL, D_FF), D_MODEL ** -0.5),
        'ffn1_w3': nrm(ks[13], (DEPTH, D_MODEL, D_FF), D_MODEL ** -0.5),
        'ffn1_w2': nrm(ks[14], (DEPTH, D_FF, D_MODEL), BETA * D_FF ** -0.5),
        'ffn2_w1': nrm(ks[15], (DEPTH, D_MODEL, D_FF), D_MODEL ** -0.5),
        'ffn2_w3': nrm(ks[16], (DEPTH, D_MODEL, D_FF), D_MODEL ** -0.5),
        'ffn2_w2': nrm(ks[17], (DEPTH, D_FF, D_MODEL), BETA * D_FF ** -0.5),
        'w_in': nrm(ks[18], (DEPTH, D_MODEL, D_IN), D_MODEL ** -0.5),
        'pool_w': nrm(ks[19], (DEPTH, POOL_GROUPS, POOL_GROUP_W, POOL_GROUP_W), POOL_GROUP_W ** -0.5),
        'pool_scale': 1.0 + nrm(ks[20], (DEPTH, POOL_WIDTH), 0.02),
        'w_pa': nrm(ks[21], (DEPTH, POOL_WIDTH, D_MODEL), POOL_WIDTH ** -0.5),
        'w_pb': nrm(ks[22], (DEPTH, DIFF_V_W, D_MODEL), DIFF_V_W ** -0.5),
        'w_pc': nrm(ks[23], (DEPTH, NA_W, D_MODEL), NA_W ** -0.5),
        'lam_q1': nrm(ks[24], (DEPTH, HEAD_DIM), 0.1),
        'lam_k1': nrm(ks[25], (DEPTH, HEAD_DIM), 0.1),
        'lam_q2': nrm(ks[26], (DEPTH, HEAD_DIM), 0.1),
        'lam_k2': nrm(ks[27], (DEPTH, HEAD_DIM), 0.1),
        'subln_g': 1.0 + nrm(ks[28], (DEPTH, 2 * HEAD_DIM), 0.02),
        'na_rpb': nrm(ks[29], (DEPTH, NA_HEADS, 2 * NA_ROWS - 1, 2 * NA_COLS - 1), 0.1),
        'w_out': nrm(ks[30], (DEPTH, D_MODEL, D_MODEL), BETA * D_MODEL ** -0.5),
    }


def reference(x_prompt, x_sample, cache_diff_k, cache_diff_v, cache_na_k, cache_na_v, c, c_ctx,
              w_mod, b_mod, ln_g, ln_b, ffn1_w1, ffn1_w3, ffn1_w2, ffn2_w1, ffn2_w3, ffn2_w2,
              w_in, pool_w, pool_scale, w_pa, w_pb, w_pc, lam_q1, lam_k1, lam_q2, lam_k2,
              subln_g, na_rpb, w_out):

    def modulation(cond, l):
        m = jax.nn.silu(cond) @ w_mod[l] + b_mod[l]
        return m.reshape(m.shape[0], 1, N_MOD, D_MODEL)

    def projections(h, l):
        b, n = h.shape[:2]
        a, qb, kb, vb, qc, kc, vc, gt = split_in(h @ w_in[l])
        return (a,
                qb.reshape(b, n, DIFF_HEADS, 2, HEAD_DIM),
                kb.reshape(b, n, DIFF_HEADS, 2, HEAD_DIM),
                vb.reshape(b, n, DIFF_HEADS, 2 * HEAD_DIM),
                qc.reshape(b, n, NA_HEADS, HEAD_DIM),
                kc.reshape(b, n, NA_HEADS, HEAD_DIM),
                vc.reshape(b, n, NA_HEADS, HEAD_DIM),
                gt)

    def diff_lambda(l):
        lam_init = 0.8 - 0.6 * math.exp(-0.3 * l)
        e1 = jnp.exp(jnp.sum(lam_q1[l].astype(jnp.float32) * lam_k1[l].astype(jnp.float32)))
        e2 = jnp.exp(jnp.sum(lam_q2[l].astype(jnp.float32) * lam_k2[l].astype(jnp.float32)))
        return e1 - e2 + lam_init, lam_init

    def merge(y_a, y_b, y_c, gt, l):
        g = jax.nn.sigmoid(gt.astype(jnp.float32)).astype(gt.dtype)
        g = g.reshape(*gt.shape[:-1], N_BRANCH, D_MODEL)
        mixed = (g[..., 0, :] * (y_a @ w_pa[l]) + g[..., 1, :] * (y_b @ w_pb[l])
                 + g[..., 2, :] * (y_c @ w_pc[l]))
        return mixed @ w_out[l]

    def mix_context(h, l):
        a, qb, kb, vb, qc, kc, vc, gt = projections(h, l)
        lam, lam_init = diff_lambda(l)
        y_a = multiscale_pool(a, pool_w[l], pool_scale[l])
        y_b = diff_attention(qb, kb, vb, lam, lam_init, subln_g[l])
        y_c = dense_attention(qc, kc, vc)
        return merge(y_a, y_b, y_c, gt, l), (kb, vb, kc, vc)

    def mix_latent(h, l):
        b, n = h.shape[:2]
        rows = n // GRID_W
        a, qb, kb, vb, qc, kc, vc, gt = projections(h, l)
        lam, lam_init = diff_lambda(l)
        y_a = multiscale_pool(a.reshape(b, rows, GRID_W, POOL_WIDTH), pool_w[l], pool_scale[l])
        y_a = y_a.reshape(b, n, POOL_WIDTH)
        k_all = jnp.concatenate([rope2d(kb), cache_diff_k[:, l]], axis=1)
        v_all = jnp.concatenate([vb, cache_diff_v[:, l]], axis=1)
        y_b = diff_attention(rope2d(qb), k_all, v_all, lam, lam_init, subln_g[l])
        y_c = neighbourhood_attention(qc, kc, vc, cache_na_k[:, l], cache_na_v[:, l], na_rpb[l])
        return merge(y_a, y_b, y_c, gt, l), None

    def block(x, m, l, mixer):
        def mod(z, i):
            return z * (1.0 + m[:, :, 3 * i + 1]) + m[:, :, 3 * i]

        h = swiglu(mod(x, 0), ffn1_w1[l], ffn1_w3[l], ffn1_w2[l])
        x = layer_norm(ALPHA * x + 0.5 * m[:, :, 2] * h, ln_g[l, 0], ln_b[l, 0])
        h, aux = mixer(mod(x, 1), l)
        x = layer_norm(ALPHA * x + m[:, :, 5] * h, ln_g[l, 1], ln_b[l, 1])
        h = swiglu(mod(x, 2), ffn2_w1[l], ffn2_w3[l], ffn2_w2[l])
        x = layer_norm(ALPHA * x + 0.5 * m[:, :, 8] * h, ln_g[l, 2], ln_b[l, 2])
        return x, aux

    x = x_prompt
    dk, dv, nk, nv = [], [], [], []
    for l in range(DEPTH):
        x, (kb, vb, kc, vc) = block(x, modulation(c_ctx[None, :], l), l, mix_context)
        dk.append(kb)
        dv.append(vb)
        nk.append(kc)
        nv.append(vc)
    y_prompt = x
    new_diff_k = jnp.stack(dk, axis=1)
    new_diff_v = jnp.stack(dv, axis=1)
    new_na_k = jnp.stack(nk, axis=1)
    new_na_v = jnp.stack(nv, axis=1)

    x = x_sample
    for l in range(DEPTH):
        x, _ = block(x, modulation(c, l), l, mix_latent)
    y_sample = x

    return (y_prompt, y_sample, new_diff_k, new_diff_v, new_na_k, new_na_v)
```

```cpp
#include <hip/hip_runtime.h>
#include <hip/hip_cooperative_groups.h>
#include <cstdio>
#include <cstdint>
namespace cg = cooperative_groups;
namespace pg8 {
#define PG8_LAS __attribute__((address_space(3)))
typedef unsigned short bf16_t;
typedef short bf16x8 __attribute__((ext_vector_type(8)));
typedef float f32x4 __attribute__((ext_vector_type(4)));
typedef unsigned u32x4 __attribute__((ext_vector_type(4)));
constexpr int BM = 256, BK = 64, HALF = 128, HTB = HALF * BK * 2  , STAGE_BYTES = 8 * HTB, NXCD = 8, WGM = 8;

__host__ __device__ __forceinline__ int lds_byte(int r, int c) { const int st = (r >> 4) * 2 + (c >> 5), rr = r & 15, cc = c & 31, ob = rr * 64 + cc * 2; return st * 1024 + (ob ^ (((ob >> 9) & 1) << 5)); }
__host__ __device__ __forceinline__ void stage_rc(int b, int& R, int& C) { const int st = b / 1024, sb = b % 1024, swz = sb ^ (((sb >> 9) & 1) << 5); R = (st >> 1) * 16 + swz / 64; C = (st & 1) * 32 + (swz % 64) / 2; }
__host__ __device__ __forceinline__ int perm32(int rho) { const int n = rho >> 4, i = rho & 15; return 8 * (i >> 2) + 4 * n + (i & 3); }

struct Unit { int pm, pn; };
struct Gemm { const bf16_t* A; const bf16_t* Bt; int M, N, K; };

struct StaticOrder {
    int nM, nN, nwg, G, c;
    __host__ __device__ void init(int M, int N, int G_, int c_) { nM = M / BM; nN = N / BM; nwg = nM * nN; G = G_; c = c_; }
    __host__ __device__ bool next(int i, Unit& u) const {
        const long L = (long)i * G + c; if (L >= nwg) return false;
        int wgid = (int)L; { const int q = nwg / NXCD, r = nwg % NXCD, xcd = wgid % NXCD, off = wgid / NXCD; wgid = (xcd < r ? xcd * (q + 1) : r * (q + 1) + (xcd - r) * q) + off; }
        const int nig = WGM * nN, gid = wgid / nig, fm = gid * WGM, gsz = (nM - fm) < WGM ? (nM - fm) : WGM;
        u.pm = fm + ((wgid % nig) % gsz); u.pn = (wgid % nig) / gsz; return true;
    }
    __device__ __forceinline__ void a_ready(const Unit&) const {}
    __device__ __forceinline__ void done(const Unit&) const {}
};


__device__ __forceinline__ unsigned cvt_pk_bf16(float lo, float hi) { unsigned r; asm volatile("v_cvt_pk_bf16_f32 %0, %1, %2" : "=v"(r) : "v"(lo), "v"(hi)); return r; }
typedef unsigned u32x2 __attribute__((ext_vector_type(2)));
__device__ __forceinline__ float sigmoidf_(float x) { return 1.0f / (1.0f + __expf(-x)); }

constexpr float kAlpha = 1.41421356237309515f;

struct EpiSwiglu {
    static constexpr bool PERM = false, AFTER_DRAIN = false, HOOK = false;
    bf16_t* U; int ldu;
    __device__ __forceinline__ void hook(f32x4 (&)[2][2][4][2], const Unit&, int, int, int, int, int) const {}
    __device__ __forceinline__ void operator()(const f32x4 (&acc)[2][2][4][2], const Unit& u, int wr, int wc, int fr, int fq) const {
        int row0 = u.pm * BM + wr * 64 + fr, col0 = u.pn * 128 + wc * 32 + 4 * fq; asm volatile("" : "+v"(row0), "+v"(col0));
#pragma unroll
        for (int ai = 0; ai < 2; ++ai)
#pragma unroll
            for (int m = 0; m < 4; ++m) { bf16_t* rowp = U + (size_t)(row0 + ai * HALF + m * 16) * ldu + col0;
#pragma unroll
                for (int n = 0; n < 2; ++n) { const f32x4 a = acc[ai][0][m][n], b = acc[ai][1][m][n]; float v[4];
#pragma unroll
                    for (int j = 0; j < 4; ++j) v[j] = a[j] * sigmoidf_(a[j]) * b[j];
                    u32x2 w; w.x = cvt_pk_bf16(v[0], v[1]); w.y = cvt_pk_bf16(v[2], v[3]); *(u32x2*)(rowp + 16 * n) = w; } }
    }
};

struct EpiResid {
    static constexpr bool PERM = false, AFTER_DRAIN = false, HOOK = false;
    float* X; const float* mod; int l, gi; float s;
    __device__ __forceinline__ void hook(f32x4 (&)[2][2][4][2], const Unit&, int, int, int, int, int) const {}
    __device__ __forceinline__ void operator()(const f32x4 (&acc)[2][2][4][2], const Unit& u, int wr, int wc, int fr, int fq) const {
        int row0 = u.pm * BM + wr * 64 + fr, col0 = u.pn * BM + wc * 32 + 4 * fq; asm volatile("" : "+v"(row0), "+v"(col0));
        const int cond = u.pm < 32 ? 0 : 1 + ((u.pm - 32) >> 3);
        const float* gate = mod + (size_t)(cond * 2 + l) * 9216 + gi * 1024 + col0;
#pragma unroll
        for (int bj = 0; bj < 2; ++bj)
#pragma unroll
            for (int n = 0; n < 2; ++n) { const f32x4 g4 = *(const f32x4*)(gate + bj * HALF + n * 16) * s;
#pragma unroll
                for (int ai = 0; ai < 2; ++ai)
#pragma unroll
                    for (int m = 0; m < 4; ++m) { float* p = X + (size_t)(row0 + ai * HALF + m * 16) * 1024 + col0 + bj * HALF + n * 16;
                        const f32x4 x = *(const f32x4*)p; *(f32x4*)p = x * kAlpha + g4 * acc[ai][bj][m][n]; } }
    }
};

struct EpiZ {
    static constexpr bool PERM = false, AFTER_DRAIN = false, HOOK = false;
    bf16_t* Z; float* out; const float* rope; int l; bf16_t* vt_cd; bf16_t* vt_cn; bf16_t* vt_ld; bf16_t* vt_ln;
    __device__ __forceinline__ void hook(f32x4 (&)[2][2][4][2], const Unit&, int, int, int, int, int) const {}
    __device__ __forceinline__ void operator()(const f32x4 (&acc)[2][2][4][2], const Unit& u, int wr, int wc, int fr, int fq) const {
        const int pn = u.pn, pm = u.pm; const bool ctx = pm < 32;
        int rt0 = wr * 64 + fr;
        int ct0 = wc * 32 + 4 * fq;
        asm volatile("" : "+v"(rt0), "+v"(ct0));
        if (pn >= 10) {
#pragma unroll
            for (int ai = 0; ai < 2; ++ai)
#pragma unroll
                for (int m = 0; m < 4; ++m) { bf16_t* rowp = Z + (size_t)(pm * BM + rt0 + ai * HALF + m * 16) * 5632 + pn * BM + ct0;
#pragma unroll
                    for (int bj = 0; bj < 2; ++bj)
#pragma unroll
                        for (int n = 0; n < 2; ++n) { const f32x4 a = acc[ai][bj][m][n]; u32x2 w; w.x = cvt_pk_bf16(sigmoidf_(a[0]), sigmoidf_(a[1])); w.y = cvt_pk_bf16(sigmoidf_(a[2]), sigmoidf_(a[3]));
                            *(u32x2*)(rowp + bj * HALF + n * 16) = w; }
                    asm volatile("" ::: "memory"); }
            return;
        }
        if (pn == 5 || pn == 6 || pn == 9) {
            const bool diff = pn != 9;
            bf16_t* vt; int pitch; int t0;
            if (ctx) { vt = (diff ? vt_cd + (size_t)pm * 4 * 128 * 256 : vt_cn + (size_t)pm * 4 * 64 * 256); pitch = 256; t0 = 0; }
            else { const int bl = (pm - 32) >> 3; t0 = ((pm - 32) & 7) * 256; pitch = 2560;
                   vt = diff ? vt_ld + (size_t)(l * 2 + bl) * 4 * 128 * 2560 : vt_ln + (size_t)(l * 2 + bl) * 4 * 64 * 2560; }
#pragma unroll
            for (int bj = 0; bj < 2; ++bj)
#pragma unroll
                for (int n = 0; n < 2; ++n) {
                    int h, dv;
                    if (diff) { h = 2 * (pn - 5) + bj; dv = ct0 + 16 * n; } else { h = 2 * bj + (wc >> 1); dv = (wc & 1) * 32 + 4 * fq + 16 * n; }
                    bf16_t* vb = vt + ((size_t)h * (diff ? 128 : 64) + dv) * pitch + t0 + rt0;
#pragma unroll
                    for (int ai = 0; ai < 2; ++ai)
#pragma unroll
                        for (int m = 0; m < 4; ++m) { const f32x4 a = acc[ai][bj][m][n]; const unsigned w0 = cvt_pk_bf16(a[0], a[1]), w1 = cvt_pk_bf16(a[2], a[3]);
                            bf16_t* p = vb + ai * HALF + m * 16;
                            p[0] = (bf16_t)(w0 & 0xffffu); p[pitch] = (bf16_t)(w0 >> 16); p[2 * pitch] = (bf16_t)(w1 & 0xffffu); p[3 * pitch] = (bf16_t)(w1 >> 16); asm volatile("" ::: "memory"); }
                }
            if (ctx) {
                float* ob = diff ? out + 20971520 + ((size_t)(pm * 2 + l) * 256) * 512 + (pn - 5) * 256 : out + 33554432 + ((size_t)(pm * 2 + l) * 256) * 256;
                const int ld = diff ? 512 : 256;
#pragma unroll
                for (int ai = 0; ai < 2; ++ai)
#pragma unroll
                    for (int m = 0; m < 4; ++m) { float* rowp = ob + (size_t)(rt0 + ai * HALF + m * 16) * ld + ct0;
#pragma unroll
                        for (int bj = 0; bj < 2; ++bj)
#pragma unroll
                            for (int n = 0; n < 2; ++n) *(f32x4*)(rowp + bj * HALF + n * 16) = acc[ai][bj][m][n];
                        asm volatile("" ::: "memory"); }
            }
            return;
        }
        const bool do_rope = !ctx && pn >= 1 && pn <= 4;
        const int trow = ((pm - 32) & 7) * 4 + wr;
#pragma unroll
        for (int ai = 0; ai < 2; ++ai)
#pragma unroll
            for (int m = 0; m < 4; ++m) {
                bf16_t* rowp = Z + (size_t)(pm * BM + rt0 + ai * HALF + m * 16) * 5632 + pn * BM + ct0;
                f32x4 c4 = {1.f, 1.f, 1.f, 1.f}, s4 = {0.f, 0.f, 0.f, 0.f};
                if (do_rope) { const int pos = (wc & 1) ? (m * 16 + fr) : (trow + 2 * ai); const float* rp = rope + pos * 32 + 4 * fq; c4 = *(const f32x4*)rp; s4 = *(const f32x4*)(rp + 16); }
#pragma unroll
                for (int bj = 0; bj < 2; ++bj) {
                    const f32x4 x1 = acc[ai][bj][m][0], x2 = acc[ai][bj][m][1];
                    const f32x4 o1 = x1 * c4 - x2 * s4, o2 = x1 * s4 + x2 * c4;
                    u32x2 w; w.x = cvt_pk_bf16(o1[0], o1[1]); w.y = cvt_pk_bf16(o1[2], o1[3]); *(u32x2*)(rowp + bj * HALF) = w;
                    w.x = cvt_pk_bf16(o2[0], o2[1]); w.y = cvt_pk_bf16(o2[2], o2[3]); *(u32x2*)(rowp + bj * HALF + 16) = w; }
                asm volatile("" ::: "memory");
            }
        if (ctx && (pn == 3 || pn == 4 || pn == 8)) {
            float* ob = pn == 8 ? out + 29360128 + ((size_t)(pm * 2 + l) * 256) * 256 : out + 12582912 + ((size_t)(pm * 2 + l) * 256) * 512 + (pn - 3) * 256;
            const int ld = pn == 8 ? 256 : 512;
#pragma unroll
            for (int ai = 0; ai < 2; ++ai)
#pragma unroll
                for (int m = 0; m < 4; ++m) { float* rowp = ob + (size_t)(rt0 + ai * HALF + m * 16) * ld + ct0;
#pragma unroll
                    for (int bj = 0; bj < 2; ++bj)
#pragma unroll
                        for (int n = 0; n < 2; ++n) *(f32x4*)(rowp + bj * HALF + n * 16) = acc[ai][bj][m][n];
                    asm volatile("" ::: "memory"); }
        }
    }
};

struct EpiMerge {
    static constexpr bool PERM = false, AFTER_DRAIN = false, HOOK = true;
    const bf16_t* Z; bf16_t* MIX;
    __device__ __forceinline__ static f32x4 gate4(const bf16_t* p) { const u32x2 w = *(const u32x2*)p; f32x4 g;
        g[0] = __uint_as_float(w.x << 16); g[1] = __uint_as_float(w.x & 0xffff0000u); g[2] = __uint_as_float(w.y << 16); g[3] = __uint_as_float(w.y & 0xffff0000u);
#pragma unroll
        for (int j = 0; j < 4; ++j) g[j] = fmaxf(g[j], 1e-18f);
        return g; }
    __device__ __forceinline__ void hook(f32x4 (&acc)[2][2][4][2], const Unit& u, int tn, int wr, int wc, int fr, int fq) const {
        if (tn != 4 && tn != 12) return;
        const int s = tn == 4 ? 0 : 1;
        int row0 = u.pm * BM + wr * 64 + fr, col0 = u.pn * BM + wc * 32 + 4 * fq; asm volatile("" : "+v"(row0), "+v"(col0));
#pragma unroll
        for (int ai = 0; ai < 2; ++ai)
#pragma unroll
            for (int m = 0; m < 4; ++m) { const bf16_t* gp = Z + (size_t)(row0 + ai * HALF + m * 16) * 5632 + 2560 + s * 1024 + col0;
#pragma unroll
                for (int bj = 0; bj < 2; ++bj)
#pragma unroll
                    for (int n = 0; n < 2; ++n) { const f32x4 ga = gate4(gp + bj * HALF + n * 16), gb = gate4(gp + 1024 + bj * HALF + n * 16); f32x4 r;
#pragma unroll
                        for (int j = 0; j < 4; ++j) r[j] = ga[j] / gb[j];
                        acc[ai][bj][m][n] = acc[ai][bj][m][n] * r; asm volatile("" ::: "memory"); }
                }
    }
    __device__ __forceinline__ void operator()(const f32x4 (&acc)[2][2][4][2], const Unit& u, int wr, int wc, int fr, int fq) const {
        int row0 = u.pm * BM + wr * 64 + fr, col0 = u.pn * BM + wc * 32 + 4 * fq; asm volatile("" : "+v"(row0), "+v"(col0));
#pragma unroll
        for (int ai = 0; ai < 2; ++ai)
#pragma unroll
            for (int m = 0; m < 4; ++m) { const size_t r = (size_t)(row0 + ai * HALF + m * 16); const bf16_t* gp = Z + r * 5632 + 2560 + 2048 + col0; bf16_t* op = MIX + r * 1024 + col0;
#pragma unroll
                for (int bj = 0; bj < 2; ++bj)
#pragma unroll
                    for (int n = 0; n < 2; ++n) { const f32x4 v = acc[ai][bj][m][n] * gate4(gp + bj * HALF + n * 16); u32x2 w; w.x = cvt_pk_bf16(v[0], v[1]); w.y = cvt_pk_bf16(v[2], v[3]);
                        *(u32x2*)(op + bj * HALF + n * 16) = w; }
                asm volatile("" ::: "memory"); }
    }
};

template <class Epi, class Sched, bool ALIGN_EPI = false, bool SP2 = false>
__device__ __forceinline__ void gemm_phase(PG8_LAS unsigned char* lds, const Gemm g, const Sched& S, const Epi& E, const int tid_in) {
    const int tid = tid_in, wid = __builtin_amdgcn_readfirstlane(tid >> 6), lane = tid & 63, wr = wid >> 2, wc = wid & 3, fr = lane & 15, fq = lane >> 4;
    const int K = g.K, nt = K / BK;
    unsigned voffA[2], voffB[2];
#pragma unroll
    for (int i = 0; i < 2; ++i) { int R, C; stage_rc(tid * 16 + i * 8192, R, C); const int Rb = Epi::PERM ? ((R & ~31) + perm32(R & 31)) : R;
        voffA[i] = (unsigned)(R * K + C) * 2u; voffB[i] = (unsigned)(Rb * K + C) * 2u; }
    const size_t kstep = (size_t)(BK * 2);
    const size_t hstep = (size_t)HALF * K * 2;
    const size_t tstep = 2 * hstep;
    const unsigned ldsw = (unsigned)wid * 1024u;
    const int aoff = lds_byte(wr * 64 + fr, fq * 8), boff = lds_byte(wc * 32 + fr, fq * 8);
#define PG8_SA(b, h) (((b) * 2 + (h)) * HTB)
#define PG8_SB(b, h) ((4 + (b) * 2 + (h)) * HTB)
#define PG8_STAGE(bufoff, gbase, voff) do { _Pragma("unroll") for (int _i = 0; _i < 2; ++_i) \
        __builtin_amdgcn_global_load_lds((const unsigned*)((const char*)(gbase) + (voff)[_i]), (PG8_LAS unsigned*)(lds + (bufoff) + ldsw + _i * 8192), 16, 0, 0); } while (0)
#define PG8_LDA(dst, b, h) do { _Pragma("unroll") for (int m = 0; m < 4; ++m) _Pragma("unroll") for (int k = 0; k < 2; ++k) dst[m][k] = *(const PG8_LAS bf16x8*)(lds + PG8_SA(b, h) + aoff + m * 2048 + k * 1024); } while (0)
#define PG8_LDB(dst, b, h) do { _Pragma("unroll") for (int n = 0; n < 2; ++n) _Pragma("unroll") for (int k = 0; k < 2; ++k) dst[n][k] = *(const PG8_LAS bf16x8*)(lds + PG8_SB(b, h) + boff + n * 2048 + k * 1024); } while (0)
#define PG8_MMA(ai, bj, At, Bt) do { __builtin_amdgcn_s_setprio(1); _Pragma("unroll") for (int m = 0; m < 4; ++m) _Pragma("unroll") for (int n = 0; n < 2; ++n) _Pragma("unroll") for (int k = 0; k < 2; ++k) \
        acc[ai][bj][m][n] = __builtin_amdgcn_mfma_f32_16x16x32_bf16(Bt[n][k], At[m][k], acc[ai][bj][m][n], 0, 0, 0); __builtin_amdgcn_s_setprio(0); } while (0)
#define PG8_WAIT_V(n) asm volatile("s_waitcnt vmcnt(" #n ")" ::: "memory")
#define PG8_WAIT_L(n) asm volatile("s_waitcnt lgkmcnt(" #n ")" ::: "memory")
#define PG8_BAR __builtin_amdgcn_s_barrier()
#define PG8_SCHED __builtin_amdgcn_sched_barrier(0)
    Unit cur, nxt; int ui = 0;
    if (!S.next(0, cur)) return;
    f32x4 acc[2][2][4][2];
#pragma unroll
    for (int a = 0; a < 2; ++a)
#pragma unroll
        for (int b = 0; b < 2; ++b)
#pragma unroll
            for (int m = 0; m < 4; ++m)
#pragma unroll
                for (int n = 0; n < 2; ++n) acc[a][b][m][n] = (f32x4){0.f, 0.f, 0.f, 0.f};
    bf16x8 At[4][2], B0[2][2], B1[2][2];
    const char* cA = (const char*)g.A + (size_t)cur.pm * tstep; const char* cB = (const char*)g.Bt + (size_t)cur.pn * tstep;
    S.a_ready(cur);
    if constexpr (SP2) {
        PG8_STAGE(PG8_SB(0, 0), cB, voffB); PG8_STAGE(PG8_SB(0, 1), cB + hstep, voffB); PG8_STAGE(PG8_SA(0, 0), cA, voffA); PG8_STAGE(PG8_SA(0, 1), cA + hstep, voffA);
        if (wr == 1) PG8_BAR;
        PG8_WAIT_V(2); PG8_BAR;
        PG8_STAGE(PG8_SB(1, 0), cB + kstep, voffB); PG8_STAGE(PG8_SA(1, 0), cA + kstep, voffA); PG8_STAGE(PG8_SB(1, 1), cB + hstep + kstep, voffB);
        PG8_WAIT_V(6); PG8_BAR;
    } else {
        PG8_STAGE(PG8_SB(0, 0), cB, voffB); PG8_STAGE(PG8_SA(0, 0), cA, voffA); PG8_STAGE(PG8_SB(0, 1), cB + hstep, voffB); PG8_STAGE(PG8_SA(0, 1), cA + hstep, voffA);
        if (wr == 1) PG8_BAR;
        PG8_WAIT_V(4); PG8_BAR;
        PG8_STAGE(PG8_SB(1, 0), cB + kstep, voffB); PG8_STAGE(PG8_SA(1, 0), cA + kstep, voffA); PG8_STAGE(PG8_SB(1, 1), cB + hstep + kstep, voffB);
        PG8_WAIT_V(6); PG8_BAR;
    }
    for (;;) {
        const bool has_next = S.next(ui + 1, nxt);
        const char* nA = has_next ? (const char*)g.A + (size_t)nxt.pm * tstep : cA; const char* nB = has_next ? (const char*)g.Bt + (size_t)nxt.pn * tstep : cB;
        for (int t = 0; t < nt; t += 2) {
            const bool last = (t == nt - 2);
            const char* a1 = cA + (size_t)(t + 1) * kstep;
            const char* a2 = last ? nA : cA + (size_t)(t + 2) * kstep; const char* b2 = last ? nB : cB + (size_t)(t + 2) * kstep;
            const char* a3 = a2 + kstep; const char* b3 = b2 + kstep;
            if (last && has_next) S.a_ready(nxt);
            if constexpr (SP2) {
            PG8_LDB(B0, 0, 0); PG8_LDB(B1, 0, 1); PG8_SCHED; PG8_LDA(At, 0, 0); PG8_STAGE(PG8_SA(1, 1), a1 + hstep, voffA);
            PG8_WAIT_V(8); PG8_WAIT_L(0); PG8_BAR; PG8_MMA(0, 0, At, B0); PG8_MMA(0, 1, At, B1); PG8_BAR; PG8_SCHED;
            PG8_LDA(At, 0, 1); PG8_STAGE(PG8_SB(0, 0), b2, voffB); PG8_STAGE(PG8_SB(0, 1), b2 + hstep, voffB); PG8_STAGE(PG8_SA(0, 0), a2, voffA);
            PG8_WAIT_V(8); PG8_WAIT_L(0); PG8_BAR; PG8_MMA(1, 0, At, B0); PG8_MMA(1, 1, At, B1); PG8_BAR; PG8_SCHED;
            PG8_LDB(B0, 1, 0); PG8_LDB(B1, 1, 1); PG8_SCHED; PG8_LDA(At, 1, 0); PG8_STAGE(PG8_SA(0, 1), a2 + hstep, voffA);
            PG8_WAIT_V(8); PG8_WAIT_L(0); PG8_BAR; PG8_MMA(0, 0, At, B0); PG8_MMA(0, 1, At, B1); PG8_BAR; PG8_SCHED;
            PG8_LDA(At, 1, 1); PG8_STAGE(PG8_SB(1, 0), b3, voffB); PG8_STAGE(PG8_SB(1, 1), b3 + hstep, voffB); PG8_STAGE(PG8_SA(1, 0), a3, voffA);
            PG8_WAIT_V(8); PG8_WAIT_L(0); PG8_BAR; PG8_MMA(1, 0, At, B0); PG8_MMA(1, 1, At, B1); PG8_BAR; PG8_SCHED;
            } else {
            PG8_LDB(B0, 0, 0); PG8_SCHED; PG8_LDA(At, 0, 0); PG8_STAGE(PG8_SA(1, 1), a1 + hstep, voffA);
            PG8_WAIT_L(8); PG8_BAR; PG8_WAIT_L(0); PG8_MMA(0, 0, At, B0); PG8_BAR; PG8_SCHED;
            PG8_LDB(B1, 0, 1); PG8_STAGE(PG8_SB(0, 0), b2, voffB);
            PG8_BAR; PG8_WAIT_L(0); PG8_MMA(0, 1, At, B1); PG8_BAR;
            PG8_LDA(At, 0, 1); PG8_STAGE(PG8_SA(0, 0), a2, voffA);
            PG8_BAR; PG8_WAIT_L(0); PG8_MMA(1, 0, At, B0); PG8_BAR; PG8_SCHED;
            PG8_STAGE(PG8_SB(0, 1), b2 + hstep, voffB);
            PG8_WAIT_V(6); PG8_BAR; PG8_MMA(1, 1, At, B1); PG8_BAR;
            PG8_LDB(B0, 1, 0); PG8_SCHED; PG8_LDA(At, 1, 0); PG8_STAGE(PG8_SA(0, 1), a2 + hstep, voffA);
            PG8_WAIT_L(8); PG8_BAR; PG8_WAIT_L(0); PG8_MMA(0, 0, At, B0); PG8_BAR; PG8_SCHED;
            PG8_LDB(B1, 1, 1); PG8_STAGE(PG8_SB(1, 0), b3, voffB);
            PG8_BAR; PG8_WAIT_L(0); PG8_MMA(0, 1, At, B1); PG8_BAR;
            PG8_LDA(At, 1, 1); PG8_STAGE(PG8_SA(1, 0), a3, voffA);
            PG8_BAR; PG8_WAIT_L(0); PG8_MMA(1, 0, At, B0); PG8_BAR; PG8_SCHED;
            PG8_STAGE(PG8_SB(1, 1), b3 + hstep, voffB);
            PG8_WAIT_V(6); PG8_BAR; PG8_MMA(1, 1, At, B1); PG8_BAR;
            }
            if constexpr (Epi::HOOK) E.hook(acc, cur, t + 2, wr, wc, fr, fq);
        }
        if constexpr (ALIGN_EPI) { if (wr == 0) PG8_BAR; }
        if constexpr (!Epi::AFTER_DRAIN) { E(acc, cur, wr, wc, fr, fq); S.done(cur); }
        if (!has_next) break;
#pragma unroll
        for (int a = 0; a < 2; ++a)
#pragma unroll
            for (int b = 0; b < 2; ++b)
#pragma unroll
                for (int m = 0; m < 4; ++m)
#pragma unroll
                    for (int n = 0; n < 2; ++n) acc[a][b][m][n] = (f32x4){0.f, 0.f, 0.f, 0.f};
        cur = nxt; cA = nA; cB = nB; ++ui;
        if constexpr (ALIGN_EPI) { if (wr == 1) PG8_BAR; }
    }
    PG8_WAIT_V(0);
    if constexpr (!ALIGN_EPI) { if (wr == 0) PG8_BAR; }
    PG8_BAR;
    if constexpr (Epi::AFTER_DRAIN) { E.fused(acc, cur, wr, wc, fr, fq, lds, wid, lane); S.done(cur); }
#undef PG8_SA
#undef PG8_SB
#undef PG8_STAGE
#undef PG8_LDA
#undef PG8_LDB
#undef PG8_MMA
#undef PG8_WAIT_V
#undef PG8_WAIT_L
#undef PG8_BAR
#undef PG8_SCHED
}
}

#define LAS __attribute__((address_space(3)))
typedef unsigned short bf16;
typedef float f32x4 __attribute__((ext_vector_type(4)));
typedef short bf16x8 __attribute__((ext_vector_type(8)));
typedef unsigned v4u __attribute__((ext_vector_type(4)));
typedef unsigned v2u __attribute__((ext_vector_type(2)));

constexpr int NWAVES = 8, NTHREADS = 512;
constexpr int M = 12288, MCTX = 8192, DM = 1024, DFF = 2816, DIN = 5632;
constexpr int LDS_BYTES = 147456;
constexpr float LN_EPS = 1e-5f, RMS_EPS = 1e-5f;
constexpr size_t MiB = 1u << 20;
constexpr size_t WS_ROPE = 64 * 1024, WS_LAM = 80 * 1024, WS_MOD = 128 * 1024;
constexpr size_t WS_W = 1 * MiB;
constexpr size_t WL_W13A = 0, WL_W2A = 11 * MiB, WL_WIN = 16 * MiB + MiB / 2, WL_WP = 27 * MiB + MiB / 2, WL_WOUT = 29 * MiB + MiB / 2, WL_W13B = 31 * MiB + MiB / 2, WL_W2B = 42 * MiB + MiB / 2, WL_SIZE = 48 * MiB;
constexpr size_t WS_UZ = 97 * MiB;
constexpr size_t WS_XM = 229 * MiB;
constexpr size_t WS_MIX = 253 * MiB;
constexpr size_t WS_VT_CD = 277 * MiB, WS_VT_CN = 285 * MiB, WS_VT_LD = 289 * MiB, WS_VT_LN = 299 * MiB, WS_CK_D = 304 * MiB, WS_CK_N = 306 * MiB, WS_END = 307 * MiB;

struct Params {
    const float* in[31];
    float* out; unsigned char* ws;
    int ph_lo, ph_hi;
};
typedef const __attribute__((address_space(4))) Params& KP;
enum { I_XP = 0, I_XS, I_CDK, I_CDV, I_CNK, I_CNV, I_C, I_CCTX, I_WMOD, I_BMOD, I_LNG, I_LNB, I_F1W1, I_F1W3, I_F1W2, I_F2W1, I_F2W3, I_F2W2, I_WIN, I_POOLW, I_POOLS, I_WPA, I_WPB, I_WPC,
       I_LQ1, I_LK1, I_LQ2, I_LK2, I_SUBG, I_RPB, I_WOUT };

__device__ __forceinline__ unsigned f2bf(float f) { unsigned u = __builtin_bit_cast(unsigned, f); return (u + 0x7fffu + ((u >> 16) & 1u)) >> 16; }
__device__ __forceinline__ unsigned pk2(float lo, float hi) { return f2bf(lo) | (f2bf(hi) << 16); }
__device__ __forceinline__ float bf2f(unsigned short h) { return __uint_as_float((unsigned)h << 16); }
__device__ __forceinline__ float wave_sum(float v) {
#pragma unroll
    for (int o = 1; o < 64; o <<= 1) v += __shfl_xor(v, o);
    return v;
}

__device__ __forceinline__ void transpose_item(const float* W, int N, int k0, int n0, bf16* dst, int dpitch, LAS float* scr, int lane) {
#pragma unroll 8
    for (int i = 0; i < 32; ++i) { const int kk = 2 * i + (lane >> 5); scr[kk * 33 + (lane & 31)] = W[(size_t)(k0 + kk) * N + n0 + (lane & 31)]; }
    asm volatile("s_waitcnt lgkmcnt(0)" ::: "memory");
    const int c = lane & 7;
#pragma unroll
    for (int j = 0; j < 4; ++j) { const int n = (lane >> 3) + 8 * j; const LAS float* s = scr + (8 * c) * 33 + n;
        v4u o; o.x = pk2(s[0 * 33], s[1 * 33]); o.y = pk2(s[2 * 33], s[3 * 33]); o.z = pk2(s[4 * 33], s[5 * 33]); o.w = pk2(s[6 * 33], s[7 * 33]);
        *(v4u*)(dst + (size_t)n * dpitch + 8 * c) = o; }
    asm volatile("s_waitcnt lgkmcnt(0)" ::: "memory");
}

__device__ __forceinline__ void prologue_phase(KP P, LAS unsigned char* lds, int tid, int lane, int wave) {
    unsigned char* ws = P.ws;
    {
        LAS float* sc = (LAS float*)lds;
        LAS float* red = (LAS float*)(lds + 12288);
        for (int i = tid; i < 3072; i += NTHREADS) { const int ci = i >> 10, k = i & 1023; const float v = ci == 0 ? P.in[I_CCTX][k] : P.in[I_C][(ci - 1) * 1024 + k]; sc[i] = v / (1.0f + __expf(-v)); }
        __syncthreads();
        float* MOD = (float*)(ws + WS_MOD);
        const int cq = tid & 15, kg = tid >> 4;
        for (int u = blockIdx.x; u < 288; u += gridDim.x) {
            const int l = u / 144, jg = u % 144;
            const float* wp = P.in[I_WMOD] + (size_t)l * 1024 * 9216 + jg * 64 + 4 * cq;
            f32x4 a0 = {0.f, 0.f, 0.f, 0.f}, a1 = a0, a2 = a0;
#pragma unroll 4
            for (int i = 0; i < 32; ++i) { const int k = kg + 32 * i; const f32x4 w = *(const f32x4*)(wp + (size_t)k * 9216); a0 += w * sc[k]; a1 += w * sc[1024 + k]; a2 += w * sc[2048 + k]; }
#pragma unroll
            for (int e = 0; e < 4; ++e) { red[(kg * 3 + 0) * 64 + 4 * cq + e] = a0[e]; red[(kg * 3 + 1) * 64 + 4 * cq + e] = a1[e]; red[(kg * 3 + 2) * 64 + 4 * cq + e] = a2[e]; }
            __syncthreads();
            if (tid < 192) { const int ci = tid >> 6, j = tid & 63; float s = 0.f;
                for (int g = 0; g < 32; ++g) s += red[(g * 3 + ci) * 64 + j];
                MOD[(size_t)(ci * 2 + l) * 9216 + jg * 64 + j] = s + P.in[I_BMOD][l * 9216 + jg * 64 + j]; }
            __syncthreads();
        }
    }
    if (blockIdx.x == 0) {
        float* rope = (float*)(ws + WS_ROPE);
        for (int i = tid; i < 1024; i += NTHREADS) { const int pos = i >> 4, f = i & 15; const float inv = powf(10000.0f, -(float)f / 16.0f); const float ang = (float)pos * inv; rope[pos * 32 + f] = cosf(ang); rope[pos * 32 + 16 + f] = sinf(ang); }
        if (wave < 2) { const int l = wave; const float d1 = wave_sum(P.in[I_LQ1][l * 64 + lane] * P.in[I_LK1][l * 64 + lane]), d2 = wave_sum(P.in[I_LQ2][l * 64 + lane] * P.in[I_LK2][l * 64 + lane]);
            const float lam_init = 0.8f - 0.6f * expf(-0.3f * (float)l);
            if (lane == 0) { float* LAM = (float*)(ws + WS_LAM); LAM[l * 2] = expf(d1) - expf(d2) + lam_init; LAM[l * 2 + 1] = 1.0f - lam_init; } }
    }
    {
        const int gt = blockIdx.x * NTHREADS + tid, NT = gridDim.x * NTHREADS;
        bf16* ckd = (bf16*)(ws + WS_CK_D); bf16* ckn = (bf16*)(ws + WS_CK_N);
        for (int i = gt; i < 1048576 / 4; i += NT) { const f32x4 v = ((const f32x4*)P.in[I_CDK])[i]; v2u o; o.x = pk2(v[0], v[1]); o.y = pk2(v[2], v[3]); ((v2u*)ckd)[i] = o; }
        for (int i = gt; i < 524288 / 4; i += NT) { const f32x4 v = ((const f32x4*)P.in[I_CNK])[i]; v2u o; o.x = pk2(v[0], v[1]); o.y = pk2(v[2], v[3]); ((v2u*)ckn)[i] = o; }
        bf16* vld = (bf16*)(ws + WS_VT_LD); bf16* vln = (bf16*)(ws + WS_VT_LN);
        for (int i = gt; i < 1048576; i += NT) {
            const int key = i & 511, dv = (i >> 9) & 127, h = (i >> 16) & 3, bl = (i >> 18) & 1, l = i >> 19;
            const float v = P.in[I_CDV][((size_t)((bl * 2 + l) * 512 + key)) * 512 + h * 128 + dv];
            vld[((size_t)((l * 2 + bl) * 4 + h) * 128 + dv) * 2560 + 2048 + key] = (bf16)f2bf(v); }
        for (int i = gt; i < 524288; i += NT) {
            const int key = i & 511, dv = (i >> 9) & 63, h = (i >> 15) & 3, bl = (i >> 17) & 1, l = i >> 18;
            const float v = P.in[I_CNV][((size_t)((bl * 2 + l) * 512 + key)) * 256 + h * 64 + dv];
            vln[((size_t)((l * 2 + bl) * 4 + h) * 64 + dv) * 2560 + 2048 + key] = (bf16)f2bf(v); }
    }
    {
        LAS float* scr = (LAS float*)(lds + 40960 + wave * 8704);
        const int gw = blockIdx.x * NWAVES + wave, NGW = gridDim.x * NWAVES;
        for (int it = gw; it < 2 * 12288; it += NGW) {
            const int l = it / 12288; int r = it % 12288;
            bf16* wl = (bf16*)(ws + WS_W + (size_t)l * WL_SIZE);
            const float* src; int N, k0, n0; bf16* dst; int dp;
            if (r < 8448) {
                const int which = r / 1408, q = r % 1408; const int ffn = which / 3, mat = which % 3;
                if (mat < 2) { N = DFF; const int kb = q / 88, nb = q % 88; k0 = 64 * kb; n0 = 32 * nb;
                    src = P.in[(ffn ? I_F2W1 : I_F1W1) + mat] + (size_t)l * 1024 * DFF;
                    dst = (bf16*)((unsigned char*)wl + (ffn ? WL_W13B : WL_W13A)) + (size_t)((n0 >> 7) * 256 + (n0 & 127) + mat * 128) * 1024 + k0; dp = 1024; }
                else { N = 1024; const int kb = q / 32, nb = q % 32; k0 = 64 * kb; n0 = 32 * nb;
                    src = P.in[ffn ? I_F2W2 : I_F1W2] + (size_t)l * DFF * 1024;
                    dst = (bf16*)((unsigned char*)wl + (ffn ? WL_W2B : WL_W2A)) + (size_t)n0 * DFF + k0; dp = DFF; }
            } else { r -= 8448;
                if (r < 2816) { N = DIN; const int kb = r / 176, nb = r % 176; k0 = 64 * kb; n0 = 32 * nb; src = P.in[I_WIN] + (size_t)l * 1024 * DIN; dst = (bf16*)((unsigned char*)wl + WL_WIN) + (size_t)n0 * 1024 + k0; dp = 1024; }
                else { r -= 2816; N = 1024; const int kb = r / 32, nb = r % 32; n0 = 32 * nb; dp = 1024;
                    if (kb < 4) { k0 = 64 * kb; src = P.in[I_WPA] + (size_t)l * 256 * 1024; dst = (bf16*)((unsigned char*)wl + WL_WP) + (size_t)n0 * 1024 + k0; }
                    else if (kb < 12) { k0 = 64 * (kb - 4); src = P.in[I_WPB] + (size_t)l * 512 * 1024; dst = (bf16*)((unsigned char*)wl + WL_WP) + (size_t)n0 * 1024 + 256 + k0; }
                    else if (kb < 16) { k0 = 64 * (kb - 12); src = P.in[I_WPC] + (size_t)l * 256 * 1024; dst = (bf16*)((unsigned char*)wl + WL_WP) + (size_t)n0 * 1024 + 768 + k0; }
                    else { k0 = 64 * (kb - 16); src = P.in[I_WOUT] + (size_t)l * 1024 * 1024; dst = (bf16*)((unsigned char*)wl + WL_WOUT) + (size_t)n0 * 1024 + k0; } }
            }
            transpose_item(src, N, k0, n0, dst, dp, scr, lane);
        }
    }
}

__device__ __forceinline__ void ln_phase(KP P, int mode, int l, int i, int nl, int ni, int lane, int wave) {
    float* X = P.out; bf16* XM = (bf16*)(P.ws + WS_XM); const float* MOD = (const float*)(P.ws + WS_MOD);
    const int gw = blockIdx.x * NWAVES + wave, NGW = gridDim.x * NWAVES;
    for (int row = gw; row < M; row += NGW) {
        const int cond = row < MCTX ? 0 : 1 + ((row - MCTX) >> 11);
        const float* src = mode ? X + (size_t)row * DM : (row < MCTX ? P.in[I_XP] + (size_t)row * DM : P.in[I_XS] + (size_t)(row - MCTX) * DM);
        f32x4 v[4];
#pragma unroll
        for (int j = 0; j < 4; ++j) v[j] = ((const f32x4*)src)[lane + 64 * j];
        if (mode) {
            float s = 0.f;
#pragma unroll
            for (int j = 0; j < 4; ++j) s += (v[j][0] + v[j][1]) + (v[j][2] + v[j][3]);
            const float mean = wave_sum(s) * (1.0f / DM); float s2 = 0.f;
#pragma unroll
            for (int j = 0; j < 4; ++j) { v[j] = v[j] - mean; s2 += (v[j][0] * v[j][0] + v[j][1] * v[j][1]) + (v[j][2] * v[j][2] + v[j][3] * v[j][3]); }
            const float rstd = 1.0f / sqrtf(wave_sum(s2) * (1.0f / DM) + LN_EPS);
            const f32x4* g = (const f32x4*)(P.in[I_LNG] + (size_t)(l * 3 + i) * DM); const f32x4* b = (const f32x4*)(P.in[I_LNB] + (size_t)(l * 3 + i) * DM);
#pragma unroll
            for (int j = 0; j < 4; ++j) v[j] = v[j] * rstd * g[lane + 64 * j] + b[lane + 64 * j];
        }
#pragma unroll
        for (int j = 0; j < 4; ++j) ((f32x4*)(X + (size_t)row * DM))[lane + 64 * j] = v[j];
        if (ni >= 0) {
            const f32x4* sh = (const f32x4*)(MOD + (size_t)(cond * 2 + nl) * 9216 + (3 * ni) * DM); const f32x4* scl = (const f32x4*)(MOD + (size_t)(cond * 2 + nl) * 9216 + (3 * ni + 1) * DM);
#pragma unroll
            for (int j = 0; j < 4; ++j) { const f32x4 o = v[j] * (scl[lane + 64 * j] + 1.0f) + sh[lane + 64 * j]; v2u w; w.x = pk2(o[0], o[1]); w.y = pk2(o[2], o[3]);
                ((v2u*)(XM + (size_t)row * DM))[lane + 64 * j] = w; }
        }
    }
}

constexpr float kScaleLog2 = 0.125f * 1.44269504088896341f;
constexpr float kLog2e = 1.44269504088896341f;
template <int NMAP, int DV> struct AState { f32x4 o[NMAP][DV / 16]; float m[NMAP], l[NMAP]; };

template <int NMAP, int DV, bool NA>
__device__ __forceinline__ void attn_seg(AState<NMAP, DV>& st, const bf16x8 (&qf)[NMAP][2], const bf16* kl, int kstride, int nkeys, const bf16* vl, int vpitch,
                                         const float* rpb, int qr, int rs, int qcol, int fq) {
    const int cs = qcol - 8 < 0 ? 0 : (qcol - 8 > 48 ? 48 : qcol - 8);
    for (int c = 0; c < nkeys; c += 32) {
        f32x4 s[NMAP][2];
#pragma unroll
        for (int mp = 0; mp < NMAP; ++mp)
#pragma unroll
            for (int t2 = 0; t2 < 2; ++t2) { const bf16* kp = kl + (size_t)(c + 16 * t2) * kstride + mp * 64;
                const bf16x8 a0 = *(const bf16x8*)kp, a1 = *(const bf16x8*)(kp + 32);
                f32x4 z = {0.f, 0.f, 0.f, 0.f};
                z = __builtin_amdgcn_mfma_f32_16x16x32_bf16(a0, qf[mp][0], z, 0, 0, 0);
                s[mp][t2] = __builtin_amdgcn_mfma_f32_16x16x32_bf16(a1, qf[mp][1], z, 0, 0, 0); }
        bf16x8 pb[NMAP];
#pragma unroll
        for (int mp = 0; mp < NMAP; ++mp) {
            float sc[8];
#pragma unroll
            for (int t2 = 0; t2 < 2; ++t2)
#pragma unroll
                for (int r = 0; r < 4; ++r) {
                    float v = s[mp][t2][r] * kScaleLog2;
                    if (NA) { const int kk = c + 16 * t2 + 4 * fq + r, kc = kk & 63, dr = rs + (kk >> 6) - qr + 7; int dc = kc - qcol; dc = dc < -15 ? -15 : (dc > 15 ? 15 : dc);
                        const bool ok = kc >= cs && kc < cs + 16;
                        v = ok ? v + rpb[dr * 31 + dc + 15] * kLog2e : -1e30f; }
                    sc[t2 * 4 + r] = v; }
            float mx = fmaxf(fmaxf(fmaxf(sc[0], sc[1]), fmaxf(sc[2], sc[3])), fmaxf(fmaxf(sc[4], sc[5]), fmaxf(sc[6], sc[7])));
            mx = fmaxf(mx, __shfl_xor(mx, 16)); mx = fmaxf(mx, __shfl_xor(mx, 32));
            const float mnew = fmaxf(st.m[mp], mx), corr = exp2f(st.m[mp] - mnew); st.m[mp] = mnew;
            float p[8], rsum = 0.f;
#pragma unroll
            for (int e = 0; e < 8; ++e) { p[e] = exp2f(sc[e] - mnew); rsum += p[e]; }
            st.l[mp] = st.l[mp] * corr + rsum;
#pragma unroll
            for (int dt = 0; dt < DV / 16; ++dt) st.o[mp][dt] = st.o[mp][dt] * corr;
            v4u w; w.x = pk2(p[0], p[1]); w.y = pk2(p[2], p[3]); w.z = pk2(p[4], p[5]); w.w = pk2(p[6], p[7]);
            pb[mp] = __builtin_bit_cast(bf16x8, w);
        }
#pragma unroll
        for (int dt = 0; dt < DV / 16; ++dt) { const bf16* vp = vl + (size_t)(16 * dt) * vpitch + c;
            const v2u lo = *(const v2u*)vp, hi = *(const v2u*)(vp + 16); v4u w; w.x = lo.x; w.y = lo.y; w.z = hi.x; w.w = hi.y; const bf16x8 a = __builtin_bit_cast(bf16x8, w);
#pragma unroll
            for (int mp = 0; mp < NMAP; ++mp) st.o[mp][dt] = __builtin_amdgcn_mfma_f32_16x16x32_bf16(a, pb[mp], st.o[mp][dt], 0, 0, 0); }
    }
}
template <int NMAP, int DV> __device__ __forceinline__ void astate_init(AState<NMAP, DV>& st) {
#pragma unroll
    for (int mp = 0; mp < NMAP; ++mp) { st.m[mp] = -1e30f; st.l[mp] = 0.f;
#pragma unroll
        for (int dt = 0; dt < DV / 16; ++dt) st.o[mp][dt] = (f32x4){0.f, 0.f, 0.f, 0.f}; }
}
__device__ __forceinline__ void load_q(bf16x8 (&q)[2], const bf16* qp) { q[0] = *(const bf16x8*)qp; q[1] = *(const bf16x8*)(qp + 32); }

__device__ __forceinline__ void diff_unit(KP P, int l, const bf16* Z, int qrow0, int h, const bf16* kA, int kAstride, int nA, const bf16* kB, int kBstride, int nB,
                                          const bf16* vt, int vpitch, int lane) {
    const int fr = lane & 15, fq = lane >> 4;
    bf16x8 qf[2][2];
    const bf16* qp = Z + (size_t)(qrow0 + fr) * DIN + 256 + h * 128 + 8 * fq;
    load_q(qf[0], qp); load_q(qf[1], qp + 64);
    AState<2, 128> st; astate_init(st);
    attn_seg<2, 128, false>(st, qf, kA + (size_t)fr * kAstride + 8 * fq, kAstride, nA, vt + (size_t)fr * vpitch + 4 * fq, vpitch, nullptr, 0, 0, 0, fq);
    if (nB > 0) attn_seg<2, 128, false>(st, qf, kB + (size_t)fr * kBstride + 8 * fq, kBstride, nB, vt + (size_t)fr * vpitch + nA + 4 * fq, vpitch, nullptr, 0, 0, 0, fq);
    float l0 = st.l[0], l1 = st.l[1];
    l0 += __shfl_xor(l0, 16); l0 += __shfl_xor(l0, 32); l1 += __shfl_xor(l1, 16); l1 += __shfl_xor(l1, 32);
    const float* LAM = (const float*)(P.ws + WS_LAM);
    const float i0 = 1.0f / l0, i1 = LAM[l * 2] / l1, post = LAM[l * 2 + 1];
    float ss = 0.f;
#pragma unroll
    for (int dt = 0; dt < 8; ++dt) { const f32x4 v = st.o[0][dt] * i0 - st.o[1][dt] * i1; st.o[0][dt] = v; ss += (v[0] * v[0] + v[1] * v[1]) + (v[2] * v[2] + v[3] * v[3]); }
    ss += __shfl_xor(ss, 16); ss += __shfl_xor(ss, 32);
    const float rms = 1.0f / sqrtf(ss * (1.0f / 128.0f) + RMS_EPS) * post;
    bf16* yp = (bf16*)(P.ws + WS_XM) + (size_t)(qrow0 + fr) * DM + 256 + h * 128 + 4 * fq;
    const float* g = P.in[I_SUBG] + l * 128 + 4 * fq;
#pragma unroll
    for (int dt = 0; dt < 8; ++dt) { const f32x4 v = st.o[0][dt] * rms * *(const f32x4*)(g + 16 * dt); v2u w; w.x = pk2(v[0], v[1]); w.y = pk2(v[2], v[3]); *(v2u*)(yp + 16 * dt) = w; }
}

template <bool NA>
__device__ __forceinline__ void na_unit(KP P, const bf16* Z, int qrow0, int h, const bf16* kA, int kAstride, int nA, const bf16* vA, const bf16* kB, int kBstride, int nB, const bf16* vB,
                                        int vpitch, const float* rpb, int qr, int rs, int w0, int lane) {
    const int fr = lane & 15, fq = lane >> 4;
    bf16x8 qf[1][2];
    load_q(qf[0], Z + (size_t)(qrow0 + fr) * DIN + 1792 + h * 64 + 8 * fq);
    AState<1, 64> st; astate_init(st);
    attn_seg<1, 64, NA>(st, qf, kA + (size_t)fr * kAstride + 8 * fq, kAstride, nA, vA + (size_t)fr * vpitch + 4 * fq, vpitch, rpb, qr, rs, w0 + fr, fq);
    if (nB > 0) attn_seg<1, 64, false>(st, qf, kB + (size_t)fr * kBstride + 8 * fq, kBstride, nB, vB + (size_t)fr * vpitch + 4 * fq, vpitch, nullptr, 0, 0, 0, fq);
    float l0 = st.l[0]; l0 += __shfl_xor(l0, 16); l0 += __shfl_xor(l0, 32);
    const float i0 = 1.0f / l0;
    bf16* yp = (bf16*)(P.ws + WS_XM) + (size_t)(qrow0 + fr) * DM + 768 + h * 64 + 4 * fq;
#pragma unroll
    for (int dt = 0; dt < 4; ++dt) { const f32x4 v = st.o[0][dt] * i0; v2u w; w.x = pk2(v[0], v[1]); w.y = pk2(v[2], v[3]); *(v2u*)(yp + 16 * dt) = w; }
}

__device__ __forceinline__ void pool_unit(KP P, int l, const bf16* Z, int tok0, LAS unsigned char* lds, int tid) {
    LAS bf16* A = (LAS bf16*)lds;
    LAS float* PP = (LAS float*)(lds + 40960);
    const bool ctx = tok0 < MCTX; const int n = ctx ? 256 : 64; const int seg0 = ctx ? (tok0 & ~255) : tok0; const int t0 = tok0 - seg0;
    for (int i = tid; i < 80 * 32; i += NTHREADS) { const int rr = i >> 5, ch = i & 31; const int t = t0 - 8 + rr; v4u v = {0u, 0u, 0u, 0u};
        if (t >= 0 && t < n) v = *(const v4u*)(Z + (size_t)(seg0 + t) * DIN + 8 * ch);
        *(LAS v4u*)(A + rr * 256 + 8 * ch) = v; }
    __syncthreads();
    { const int c = tid & 255, half = tid >> 8, g = c >> 6, hw = 1 << g;
        for (int i = half * 32; i < half * 32 + 32; ++i) { const int t = t0 + i; const int lo = t - hw < 0 ? 0 : t - hw, hi = t + hw > n ? n : t + hw; float s = 0.f;
            for (int tt = lo; tt < hi; ++tt) s += bf2f(A[(tt - t0 + 8) * 256 + c]);
            PP[i * 256 + c] = s / (float)(hi - lo) - bf2f(A[(i + 8) * 256 + c]); } }
    __syncthreads();
    { const int gd = tid & 255, half = tid >> 8, g = gd >> 6, d = gd & 63;
        const float* w = P.in[I_POOLW] + (size_t)((l * 4 + g) * 64) * 64 + d;
        float acc[32];
#pragma unroll
        for (int i = 0; i < 32; ++i) acc[i] = 0.f;
        for (int c = 0; c < 64; c += 4) { const float w0 = w[(c + 0) * 64], w1 = w[(c + 1) * 64], w2 = w[(c + 2) * 64], w3 = w[(c + 3) * 64];
#pragma unroll
            for (int i = 0; i < 32; ++i) { const f32x4 pv = *(const LAS f32x4*)(PP + (half * 32 + i) * 256 + g * 64 + c); acc[i] += (pv[0] * w0 + pv[1] * w1) + (pv[2] * w2 + pv[3] * w3); } }
        const float scl = P.in[I_POOLS][l * 256 + gd];
        bf16* yp = (bf16*)(P.ws + WS_XM) + (size_t)(tok0 + half * 32) * DM + gd;
#pragma unroll
        for (int i = 0; i < 32; ++i) yp[(size_t)i * DM] = (bf16)f2bf(acc[i] * scl);
    }
    __syncthreads();
}

__device__ __forceinline__ void att_phase(KP P, int l, LAS unsigned char* lds, int tid, int lane, int wave) {
    const bf16* Z = (const bf16*)(P.ws + WS_UZ);
    for (int u = blockIdx.x; u < 960; u += gridDim.x) {
        if (u < 128) {
            const int bl = u >> 6, h = (u >> 4) & 3, qb = u & 15; const int row0 = MCTX + bl * 2048;
            diff_unit(P, l, Z, row0 + qb * 128 + wave * 16, h, Z + (size_t)row0 * DIN + 768 + h * 128, DIN, 2048,
                      (const bf16*)(P.ws + WS_CK_D) + (size_t)(bl * 2 + l) * 512 * 512 + h * 128, 512, 512,
                      (const bf16*)(P.ws + WS_VT_LD) + (size_t)((l * 2 + bl) * 4 + h) * 128 * 2560, 2560, lane);
        } else if (u < 384) {
            const int v = u - 128, b = v >> 3, h = (v >> 1) & 3, qb = v & 1; const int row0 = b * 256;
            diff_unit(P, l, Z, row0 + qb * 128 + wave * 16, h, Z + (size_t)row0 * DIN + 768 + h * 128, DIN, 256, nullptr, 0, 0,
                      (const bf16*)(P.ws + WS_VT_CD) + (size_t)(b * 4 + h) * 128 * 256, 256, lane);
        } else if (u < 512) {
            const int v = u - 384, bl = v >> 6, h = (v >> 4) & 3, rb = v & 15; const int row0 = MCTX + bl * 2048;
            const int qr = 2 * rb + (wave >> 2), w0 = (wave & 3) * 16; const int rs = qr - 4 < 0 ? 0 : (qr - 4 > 24 ? 24 : qr - 4);
            const bf16* vt = (const bf16*)(P.ws + WS_VT_LN) + (size_t)((l * 2 + bl) * 4 + h) * 64 * 2560;
            na_unit<true>(P, Z, row0 + qr * 64 + w0, h, Z + (size_t)(row0 + rs * 64) * DIN + 2048 + h * 64, DIN, 512, vt + rs * 64,
                          (const bf16*)(P.ws + WS_CK_N) + (size_t)(bl * 2 + l) * 512 * 256 + h * 64, 256, 512, vt + 2048, 2560,
                          P.in[I_RPB] + (size_t)(l * 4 + h) * 465, qr, rs, w0, lane);
        } else if (u < 768) {
            const int v = u - 512, b = v >> 3, h = (v >> 1) & 3, qb = v & 1; const int row0 = b * 256;
            na_unit<false>(P, Z, row0 + qb * 128 + wave * 16, h, Z + (size_t)row0 * DIN + 2048 + h * 64, DIN, 256, (const bf16*)(P.ws + WS_VT_CN) + (size_t)(b * 4 + h) * 64 * 256,
                           nullptr, 0, 0, nullptr, 256, nullptr, 0, 0, 0, lane);
        } else {
            pool_unit(P, l, Z, (u - 768) * 64, lds, tid);
        }
    }
}

constexpr int N_PHASES = 24;
__global__ void __launch_bounds__(NTHREADS, 2) fwd_kernel(Params P0) {
    extern __shared__ __attribute__((aligned(16))) unsigned char lds_raw[];
    LAS unsigned char* lds = (LAS unsigned char*)lds_raw;
    cg::grid_group grid = cg::this_grid();
    const int ph_lo = P0.ph_lo, ph_hi = P0.ph_hi;
    for (int ph = ph_lo; ph < ph_hi; ++ph) {
        const __attribute__((address_space(4))) Params* kp = (const __attribute__((address_space(4))) Params*)__builtin_amdgcn_kernarg_segment_ptr();
        asm volatile("" : "+s"(kp));
        KP P = *kp;
        unsigned char* ws = P.ws;
        int tid = threadIdx.x; asm volatile("" : "+v"(tid));
        const int lane = tid & 63, wave = __builtin_amdgcn_readfirstlane(tid >> 6);
#ifndef NO_PRO
        if (ph == 0) prologue_phase(P, lds, tid, lane, wave);
#else
        if (ph == 0) {}
#endif
        else if (ph == 1) ln_phase(P, 0, 0, 0, 0, 0, lane, wave);
        else {
            const int q = ph - 2, l = q / 11, s = q % 11;
            unsigned char* wl = ws + WS_W + (size_t)l * WL_SIZE;
            if (s == 0 || s == 8) {
                pg8::Gemm g{(const pg8::bf16_t*)(ws + WS_XM), (const pg8::bf16_t*)(wl + (s == 0 ? WL_W13A : WL_W13B)), M, DIN, DM}; pg8::StaticOrder S; S.init(M, DIN, gridDim.x, blockIdx.x);
                pg8::EpiSwiglu E{(pg8::bf16_t*)(ws + WS_UZ), DFF};
#ifndef NO_G1
                pg8::gemm_phase<pg8::EpiSwiglu, pg8::StaticOrder, true, true>(lds, g, S, E, tid);
#endif
            } else if (s == 1 || s == 6 || s == 9) {
                const pg8::bf16_t* A = (const pg8::bf16_t*)(ws + (s == 6 ? WS_MIX : WS_UZ)); const pg8::bf16_t* B = (const pg8::bf16_t*)(wl + (s == 1 ? WL_W2A : (s == 6 ? WL_WOUT : WL_W2B)));
                pg8::Gemm g{A, B, M, DM, s == 6 ? DM : DFF}; pg8::StaticOrder S; S.init(M, DM, gridDim.x, blockIdx.x);
                pg8::EpiResid E{P.out, (const float*)(ws + WS_MOD), l, s == 1 ? 2 : (s == 6 ? 5 : 8), s == 6 ? 1.0f : 0.5f};
#ifndef NO_G2
                pg8::gemm_phase<pg8::EpiResid, pg8::StaticOrder, true, true>(lds, g, S, E, tid);
#endif
            } else if (s == 2 || s == 7 || s == 10) {
                const int i = s == 2 ? 0 : (s == 7 ? 1 : 2);
                int nl = l, ni = i + 1; if (i == 2) { nl = l + 1; ni = nl < 2 ? 0 : -1; }
                ln_phase(P, 1, l, i, nl, ni, lane, wave);
            } else if (s == 3) {
                pg8::Gemm g{(const pg8::bf16_t*)(ws + WS_XM), (const pg8::bf16_t*)(wl + WL_WIN), M, DIN, DM}; pg8::StaticOrder S; S.init(M, DIN, gridDim.x, blockIdx.x);
                pg8::EpiZ E{(pg8::bf16_t*)(ws + WS_UZ), P.out, (const float*)(ws + WS_ROPE), l, (pg8::bf16_t*)(ws + WS_VT_CD), (pg8::bf16_t*)(ws + WS_VT_CN), (pg8::bf16_t*)(ws + WS_VT_LD), (pg8::bf16_t*)(ws + WS_VT_LN)};
#ifndef NO_G3
                pg8::gemm_phase<pg8::EpiZ, pg8::StaticOrder, true, true>(lds, g, S, E, tid);
#endif
            } else if (s == 4) {
#ifndef NO_ATT
                att_phase(P, l, lds, tid, lane, wave);
#endif
            } else {
                pg8::Gemm g{(const pg8::bf16_t*)(ws + WS_XM), (const pg8::bf16_t*)(wl + WL_WP), M, DM, DM}; pg8::StaticOrder S; S.init(M, DM, gridDim.x, blockIdx.x);
                pg8::EpiMerge E{(const pg8::bf16_t*)(ws + WS_UZ), (pg8::bf16_t*)(ws + WS_MIX)};
#ifndef NO_G4
                pg8::gemm_phase<pg8::EpiMerge, pg8::StaticOrder, true, true>(lds, g, S, E, tid);
#endif
            }
        }
        if (ph + 1 < ph_hi) grid.sync();
    }
}

#ifndef MK_PER_PHASE
#define MK_PER_PHASE 0
#endif
extern "C" void kernel_launch(void* const* d_in, const int* in_sizes, int n_in, void* d_out, int out_size, void* d_ws, size_t ws_size, hipStream_t stream) {
    static int grid = 0;
    if (grid == 0) {
        if (n_in != 31 || ws_size < WS_END) { fprintf(stderr, "kernel_launch: need 31 inputs and %zu bytes of workspace (got %d, %zu)\n", (size_t)WS_END, n_in, ws_size); grid = -1; return; }
        int dev = 0, cus = 0, per_cu = 0;
        hipGetDevice(&dev); hipDeviceGetAttribute(&cus, hipDeviceAttributeMultiprocessorCount, dev);
        if (hipFuncSetAttribute((const void*)fwd_kernel, hipFuncAttributeMaxDynamicSharedMemorySize, LDS_BYTES) != hipSuccess) { fprintf(stderr, "kernel_launch: hipFuncSetAttribute failed\n"); grid = -1; return; }
        if (hipOccupancyMaxActiveBlocksPerMultiprocessor(&per_cu, (const void*)fwd_kernel, NTHREADS, LDS_BYTES) != hipSuccess || per_cu < 1) { fprintf(stderr, "kernel_launch: occupancy query says %d\n", per_cu); per_cu = 1; }
        (void)hipGetLastError();
        grid = cus * 1;
        fprintf(stderr, "kernel_launch: grid %d (cus %d, per_cu %d)\n", grid, cus, per_cu);
    }
    if (grid < 0) return;
    Params p{};
    for (int i = 0; i < 31; ++i) p.in[i] = (const float*)d_in[i];
    p.out = (float*)d_out; p.ws = (unsigned char*)d_ws;
#if MK_PER_PHASE
    for (int ph = 0; ph < N_PHASES; ++ph) { p.ph_lo = ph; p.ph_hi = ph + 1; hipLaunchKernelGGL(fwd_kernel, dim3(grid), dim3(NTHREADS), LDS_BYTES, stream, p); }
#else
    p.ph_lo = 0; p.ph_hi = N_PHASES;
    void* args[] = {&p};
    const hipError_t e = hipLaunchCooperativeKernel((const void*)fwd_kernel, dim3(grid), dim3(NTHREADS), args, LDS_BYTES, stream);
    if (e != hipSuccess) fprintf(stderr, "kernel_launch: cooperative launch failed: %s (grid %d)\n", hipGetErrorString(e), grid);
#endif
}
```

```cpp
#ifndef PROBE_SYNC
#define PROBE_SYNC 0
#endif
#ifndef PROBE_ATT
#define PROBE_ATT 0
#endif
#include <hip/hip_runtime.h>
#include <hip/hip_cooperative_groups.h>
#include <cstdio>
#include <cstdint>
namespace cg = cooperative_groups;
namespace pg8 {
#define PG8_LAS __attribute__((address_space(3)))
typedef unsigned short bf16_t;
typedef short bf16x8 __attribute__((ext_vector_type(8)));
typedef float f32x4 __attribute__((ext_vector_type(4)));
typedef unsigned u32x4 __attribute__((ext_vector_type(4)));
constexpr int BM = 256, BK = 64, HALF = 128, HTB = HALF * BK * 2  , STAGE_BYTES = 8 * HTB, NXCD = 8, WGM = 8;

__host__ __device__ __forceinline__ int lds_byte(int r, int c) { const int st = (r >> 4) * 2 + (c >> 5), rr = r & 15, cc = c & 31, ob = rr * 64 + cc * 2; return st * 1024 + (ob ^ (((ob >> 9) & 1) << 5)); }
__host__ __device__ __forceinline__ void stage_rc(int b, int& R, int& C) { const int st = b / 1024, sb = b % 1024, swz = sb ^ (((sb >> 9) & 1) << 5); R = (st >> 1) * 16 + swz / 64; C = (st & 1) * 32 + (swz % 64) / 2; }
__host__ __device__ __forceinline__ int perm32(int rho) { const int n = rho >> 4, i = rho & 15; return 8 * (i >> 2) + 4 * n + (i & 3); }

struct Unit { int pm, pn; };
struct Gemm { const bf16_t* A; const bf16_t* Bt; int M, N, K; };

struct StaticOrder {
    int nM, nN, nwg, G, c;
    __host__ __device__ void init(int M, int N, int G_, int c_) { nM = M / BM; nN = N / BM; nwg = nM * nN; G = G_; c = c_; }
    __host__ __device__ bool next(int i, Unit& u) const {
        const long L = (long)i * G + c; if (L >= nwg) return false;
        int wgid = (int)L; { const int q = nwg / NXCD, r = nwg % NXCD, xcd = wgid % NXCD, off = wgid / NXCD; wgid = (xcd < r ? xcd * (q + 1) : r * (q + 1) + (xcd - r) * q) + off; }
        const int nig = WGM * nN, gid = wgid / nig, fm = gid * WGM, gsz = (nM - fm) < WGM ? (nM - fm) : WGM;
        u.pm = fm + ((wgid % nig) % gsz); u.pn = (wgid % nig) / gsz; return true;
    }
    __device__ __forceinline__ void a_ready(const Unit&) const {}
    __device__ __forceinline__ void done(const Unit&) const {}
};


__device__ __forceinline__ unsigned cvt_pk_bf16(float lo, float hi) { unsigned r; asm volatile("v_cvt_pk_bf16_f32 %0, %1, %2" : "=v"(r) : "v"(lo), "v"(hi)); return r; }
typedef unsigned u32x2 __attribute__((ext_vector_type(2)));
__device__ __forceinline__ float sigmoidf_(float x) { return 1.0f / (1.0f + __expf(-x)); }

constexpr float kAlpha = 1.41421356237309515f;

struct EpiSwiglu {
    static constexpr bool PERM = false, AFTER_DRAIN = false, HOOK = false;
    bf16_t* U; int ldu;
    __device__ __forceinline__ void hook(f32x4 (&)[2][2][4][2], const Unit&, int, int, int, int, int) const {}
    __device__ __forceinline__ void operator()(const f32x4 (&acc)[2][2][4][2], const Unit& u, int wr, int wc, int fr, int fq) const {
        int row0 = u.pm * BM + wr * 64 + fr, col0 = u.pn * 128 + wc * 32 + 4 * fq; asm volatile("" : "+v"(row0), "+v"(col0));
#pragma unroll
        for (int ai = 0; ai < 2; ++ai)
#pragma unroll
            for (int m = 0; m < 4; ++m) { bf16_t* rowp = U + (size_t)(row0 + ai * HALF + m * 16) * ldu + col0;
#pragma unroll
                for (int n = 0; n < 2; ++n) { const f32x4 a = acc[ai][0][m][n], b = acc[ai][1][m][n]; float v[4];
#pragma unroll
                    for (int j = 0; j < 4; ++j) v[j] = a[j] * sigmoidf_(a[j]) * b[j];
                    u32x2 w; w.x = cvt_pk_bf16(v[0], v[1]); w.y = cvt_pk_bf16(v[2], v[3]); *(u32x2*)(rowp + 16 * n) = w; } }
    }
};

struct EpiResid {
    static constexpr bool PERM = false, AFTER_DRAIN = false, HOOK = false;
    float* X; const float* mod; int l, gi; float s;
    __device__ __forceinline__ void hook(f32x4 (&)[2][2][4][2], const Unit&, int, int, int, int, int) const {}
    __device__ __forceinline__ void operator()(const f32x4 (&acc)[2][2][4][2], const Unit& u, int wr, int wc, int fr, int fq) const {
        int row0 = u.pm * BM + wr * 64 + fr, col0 = u.pn * BM + wc * 32 + 4 * fq; asm volatile("" : "+v"(row0), "+v"(col0));
        const int cond = u.pm < 32 ? 0 : 1 + ((u.pm - 32) >> 3);
        const float* gate = mod + (size_t)(cond * 2 + l) * 9216 + gi * 1024 + col0;
#pragma unroll
        for (int bj = 0; bj < 2; ++bj)
#pragma unroll
            for (int n = 0; n < 2; ++n) { const f32x4 g4 = *(const f32x4*)(gate + bj * HALF + n * 16) * s;
#pragma unroll
                for (int ai = 0; ai < 2; ++ai)
#pragma unroll
                    for (int m = 0; m < 4; ++m) { float* p = X + (size_t)(row0 + ai * HALF + m * 16) * 1024 + col0 + bj * HALF + n * 16;
                        const f32x4 x = *(const f32x4*)p; *(f32x4*)p = x * kAlpha + g4 * acc[ai][bj][m][n]; } }
    }
};

struct EpiZ {
    static constexpr bool PERM = false, AFTER_DRAIN = false, HOOK = false;
    bf16_t* Z; float* out; const float* rope; int l; bf16_t* vt_cd; bf16_t* vt_cn; bf16_t* vt_ld; bf16_t* vt_ln;
    __device__ __forceinline__ void hook(f32x4 (&)[2][2][4][2], const Unit&, int, int, int, int, int) const {}
    __device__ __forceinline__ void operator()(const f32x4 (&acc)[2][2][4][2], const Unit& u, int wr, int wc, int fr, int fq) const {
        const int pn = u.pn, pm = u.pm; const bool ctx = pm < 32;
        int rt0 = wr * 64 + fr;
        int ct0 = wc * 32 + 4 * fq;
        asm volatile("" : "+v"(rt0), "+v"(ct0));
        if (pn >= 10) {
#pragma unroll
            for (int ai = 0; ai < 2; ++ai)
#pragma unroll
                for (int m = 0; m < 4; ++m) { bf16_t* rowp = Z + (size_t)(pm * BM + rt0 + ai * HALF + m * 16) * 5632 + pn * BM + ct0;
#pragma unroll
                    for (int bj = 0; bj < 2; ++bj)
#pragma unroll
                        for (int n = 0; n < 2; ++n) { const f32x4 a = acc[ai][bj][m][n]; u32x2 w; w.x = cvt_pk_bf16(sigmoidf_(a[0]), sigmoidf_(a[1])); w.y = cvt_pk_bf16(sigmoidf_(a[2]), sigmoidf_(a[3]));
                            *(u32x2*)(rowp + bj * HALF + n * 16) = w; }
                    asm volatile("" ::: "memory"); }
            return;
        }
        if (pn == 5 || pn == 6 || pn == 9) {
            const bool diff = pn != 9;
            bf16_t* vt; int pitch; int t0;
            if (ctx) { vt = (diff ? vt_cd + (size_t)pm * 4 * 128 * 256 : vt_cn + (size_t)pm * 4 * 64 * 256); pitch = 256; t0 = 0; }
            else { const int bl = (pm - 32) >> 3; t0 = ((pm - 32) & 7) * 256; pitch = 2560;
                   vt = diff ? vt_ld + (size_t)(l * 2 + bl) * 4 * 128 * 2560 : vt_ln + (size_t)(l * 2 + bl) * 4 * 64 * 2560; }
#pragma unroll
            for (int bj = 0; bj < 2; ++bj)
#pragma unroll
                for (int n = 0; n < 2; ++n) {
                    int h, dv;
                    if (diff) { h = 2 * (pn - 5) + bj; dv = ct0 + 16 * n; } else { h = 2 * bj + (wc >> 1); dv = (wc & 1) * 32 + 4 * fq + 16 * n; }
                    bf16_t* vb = vt + ((size_t)h * (diff ? 128 : 64) + dv) * pitch + t0 + rt0;
#pragma unroll
                    for (int ai = 0; ai < 2; ++ai)
#pragma unroll
                        for (int m = 0; m < 4; ++m) { const f32x4 a = acc[ai][bj][m][n]; const unsigned w0 = cvt_pk_bf16(a[0], a[1]), w1 = cvt_pk_bf16(a[2], a[3]);
                            bf16_t* p = vb + ai * HALF + m * 16;
                            p[0] = (bf16_t)(w0 & 0xffffu); p[pitch] = (bf16_t)(w0 >> 16); p[2 * pitch] = (bf16_t)(w1 & 0xffffu); p[3 * pitch] = (bf16_t)(w1 >> 16); asm volatile("" ::: "memory"); }
                }
            if (ctx) {
                float* ob = diff ? out + 20971520 + ((size_t)(pm * 2 + l) * 256) * 512 + (pn - 5) * 256 : out + 33554432 + ((size_t)(pm * 2 + l) * 256) * 256;
                const int ld = diff ? 512 : 256;
#pragma unroll
                for (int ai = 0; ai < 2; ++ai)
#pragma unroll
                    for (int m = 0; m < 4; ++m) { float* rowp = ob + (size_t)(rt0 + ai * HALF + m * 16) * ld + ct0;
#pragma unroll
                        for (int bj = 0; bj < 2; ++bj)
#pragma unroll
                            for (int n = 0; n < 2; ++n) *(f32x4*)(rowp + bj * HALF + n * 16) = acc[ai][bj][m][n];
                        asm volatile("" ::: "memory"); }
            }
            return;
        }
        const bool do_rope = !ctx && pn >= 1 && pn <= 4;
        const int trow = ((pm - 32) & 7) * 4 + wr;
#pragma unroll
        for (int ai = 0; ai < 2; ++ai)
#pragma unroll
            for (int m = 0; m < 4; ++m) {
                bf16_t* rowp = Z + (size_t)(pm * BM + rt0 + ai * HALF + m * 16) * 5632 + pn * BM + ct0;
                f32x4 c4 = {1.f, 1.f, 1.f, 1.f}, s4 = {0.f, 0.f, 0.f, 0.f};
                if (do_rope) { const int pos = (wc & 1) ? (m * 16 + fr) : (trow + 2 * ai); const float* rp = rope + pos * 32 + 4 * fq; c4 = *(const f32x4*)rp; s4 = *(const f32x4*)(rp + 16); }
#pragma unroll
                for (int bj = 0; bj < 2; ++bj) {
                    const f32x4 x1 = acc[ai][bj][m][0], x2 = acc[ai][bj][m][1];
                    const f32x4 o1 = x1 * c4 - x2 * s4, o2 = x1 * s4 + x2 * c4;
                    u32x2 w; w.x = cvt_pk_bf16(o1[0], o1[1]); w.y = cvt_pk_bf16(o1[2], o1[3]); *(u32x2*)(rowp + bj * HALF) = w;
                    w.x = cvt_pk_bf16(o2[0], o2[1]); w.y = cvt_pk_bf16(o2[2], o2[3]); *(u32x2*)(rowp + bj * HALF + 16) = w; }
                asm volatile("" ::: "memory");
            }
        if (ctx && (pn == 3 || pn == 4 || pn == 8)) {
            float* ob = pn == 8 ? out + 29360128 + ((size_t)(pm * 2 + l) * 256) * 256 : out + 12582912 + ((size_t)(pm * 2 + l) * 256) * 512 + (pn - 3) * 256;
            const int ld = pn == 8 ? 256 : 512;
#pragma unroll
            for (int ai = 0; ai < 2; ++ai)
#pragma unroll
                for (int m = 0; m < 4; ++m) { float* rowp = ob + (size_t)(rt0 + ai * HALF + m * 16) * ld + ct0;
#pragma unroll
                    for (int bj = 0; bj < 2; ++bj)
#pragma unroll
                        for (int n = 0; n < 2; ++n) *(f32x4*)(rowp + bj * HALF + n * 16) = acc[ai][bj][m][n];
                    asm volatile("" ::: "memory"); }
        }
    }
};

struct EpiMerge {
    static constexpr bool PERM = false, AFTER_DRAIN = false, HOOK = true;
    const bf16_t* Z; bf16_t* MIX;
    __device__ __forceinline__ static f32x4 gate4(const bf16_t* p) { const u32x2 w = *(const u32x2*)p; f32x4 g;
        g[0] = __uint_as_float(w.x << 16); g[1] = __uint_as_float(w.x & 0xffff0000u); g[2] = __uint_as_float(w.y << 16); g[3] = __uint_as_float(w.y & 0xffff0000u);
#pragma unroll
        for (int j = 0; j < 4; ++j) g[j] = fmaxf(g[j], 1e-18f);
        return g; }
    __device__ __forceinline__ void hook(f32x4 (&acc)[2][2][4][2], const Unit& u, int tn, int wr, int wc, int fr, int fq) const {
        if (tn != 4 && tn != 12) return;
        const int s = tn == 4 ? 0 : 1;
        int row0 = u.pm * BM + wr * 64 + fr, col0 = u.pn * BM + wc * 32 + 4 * fq; asm volatile("" : "+v"(row0), "+v"(col0));
#pragma unroll
        for (int ai = 0; ai < 2; ++ai)
#pragma unroll
            for (int m = 0; m < 4; ++m) { const bf16_t* gp = Z + (size_t)(row0 + ai * HALF + m * 16) * 5632 + 2560 + s * 1024 + col0;
#pragma unroll
                for (int bj = 0; bj < 2; ++bj)
#pragma unroll
                    for (int n = 0; n < 2; ++n) { const f32x4 ga = gate4(gp + bj * HALF + n * 16), gb = gate4(gp + 1024 + bj * HALF + n * 16); f32x4 r;
#pragma unroll
                        for (int j = 0; j < 4; ++j) r[j] = ga[j] / gb[j];
                        acc[ai][bj][m][n] = acc[ai][bj][m][n] * r; asm volatile("" ::: "memory"); }
                }
    }
    __device__ __forceinline__ void operator()(const f32x4 (&acc)[2][2][4][2], const Unit& u, int wr, int wc, int fr, int fq) const {
        int row0 = u.pm * BM + wr * 64 + fr, col0 = u.pn * BM + wc * 32 + 4 * fq; asm volatile("" : "+v"(row0), "+v"(col0));
#pragma unroll
        for (int ai = 0; ai < 2; ++ai)
#pragma unroll
            for (int m = 0; m < 4; ++m) { const size_t r = (size_t)(row0 + ai * HALF + m * 16); const bf16_t* gp = Z + r * 5632 + 2560 + 2048 + col0; bf16_t* op = MIX + r * 1024 + col0;
#pragma unroll
                for (int bj = 0; bj < 2; ++bj)
#pragma unroll
                    for (int n = 0; n < 2; ++n) { const f32x4 v = acc[ai][bj][m][n] * gate4(gp + bj * HALF + n * 16); u32x2 w; w.x = cvt_pk_bf16(v[0], v[1]); w.y = cvt_pk_bf16(v[2], v[3]);
                        *(u32x2*)(op + bj * HALF + n * 16) = w; }
                asm volatile("" ::: "memory"); }
    }
};

template <class Epi, class Sched, bool ALIGN_EPI = false, bool SP2 = false>
__device__ __forceinline__ void gemm_phase(PG8_LAS unsigned char* lds, const Gemm g, const Sched& S, const Epi& E, const int tid_in) {
    const int tid = tid_in, wid = __builtin_amdgcn_readfirstlane(tid >> 6), lane = tid & 63, wr = wid >> 2, wc = wid & 3, fr = lane & 15, fq = lane >> 4;
    const int K = g.K, nt = K / BK;
    unsigned voffA[2], voffB[2];
#pragma unroll
    for (int i = 0; i < 2; ++i) { int R, C; stage_rc(tid * 16 + i * 8192, R, C); const int Rb = Epi::PERM ? ((R & ~31) + perm32(R & 31)) : R;
        voffA[i] = (unsigned)(R * K + C) * 2u; voffB[i] = (unsigned)(Rb * K + C) * 2u; }
    const size_t kstep = (size_t)(BK * 2);
    const size_t hstep = (size_t)HALF * K * 2;
    const size_t tstep = 2 * hstep;
    const unsigned ldsw = (unsigned)wid * 1024u;
    const int aoff = lds_byte(wr * 64 + fr, fq * 8), boff = lds_byte(wc * 32 + fr, fq * 8);
#define PG8_SA(b, h) (((b) * 2 + (h)) * HTB)
#define PG8_SB(b, h) ((4 + (b) * 2 + (h)) * HTB)
#define PG8_STAGE(bufoff, gbase, voff) do { _Pragma("unroll") for (int _i = 0; _i < 2; ++_i) \
        __builtin_amdgcn_global_load_lds((const unsigned*)((const char*)(gbase) + (voff)[_i]), (PG8_LAS unsigned*)(lds + (bufoff) + ldsw + _i * 8192), 16, 0, 0); } while (0)
#define PG8_LDA(dst, b, h) do { _Pragma("unroll") for (int m = 0; m < 4; ++m) _Pragma("unroll") for (int k = 0; k < 2; ++k) dst[m][k] = *(const PG8_LAS bf16x8*)(lds + PG8_SA(b, h) + aoff + m * 2048 + k * 1024); } while (0)
#define PG8_LDB(dst, b, h) do { _Pragma("unroll") for (int n = 0; n < 2; ++n) _Pragma("unroll") for (int k = 0; k < 2; ++k) dst[n][k] = *(const PG8_LAS bf16x8*)(lds + PG8_SB(b, h) + boff + n * 2048 + k * 1024); } while (0)
#define PG8_MMA(ai, bj, At, Bt) do { __builtin_amdgcn_s_setprio(1); _Pragma("unroll") for (int m = 0; m < 4; ++m) _Pragma("unroll") for (int n = 0; n < 2; ++n) _Pragma("unroll") for (int k = 0; k < 2; ++k) \
        acc[ai][bj][m][n] = __builtin_amdgcn_mfma_f32_16x16x32_bf16(Bt[n][k], At[m][k], acc[ai][bj][m][n], 0, 0, 0); __builtin_amdgcn_s_setprio(0); } while (0)
#define PG8_WAIT_V(n) asm volatile("s_waitcnt vmcnt(" #n ")" ::: "memory")
#define PG8_WAIT_L(n) asm volatile("s_waitcnt lgkmcnt(" #n ")" ::: "memory")
#define PG8_BAR __builtin_amdgcn_s_barrier()
#define PG8_SCHED __builtin_amdgcn_sched_barrier(0)
    Unit cur, nxt; int ui = 0;
    if (!S.next(0, cur)) return;
    f32x4 acc[2][2][4][2];
#pragma unroll
    for (int a = 0; a < 2; ++a)
#pragma unroll
        for (int b = 0; b < 2; ++b)
#pragma unroll
            for (int m = 0; m < 4; ++m)
#pragma unroll
                for (int n = 0; n < 2; ++n) acc[a][b][m][n] = (f32x4){0.f, 0.f, 0.f, 0.f};
    bf16x8 At[4][2], B0[2][2], B1[2][2];
    const char* cA = (const char*)g.A + (size_t)cur.pm * tstep; const char* cB = (const char*)g.Bt + (size_t)cur.pn * tstep;
    S.a_ready(cur);
    if constexpr (SP2) {
        PG8_STAGE(PG8_SB(0, 0), cB, voffB); PG8_STAGE(PG8_SB(0, 1), cB + hstep, voffB); PG8_STAGE(PG8_SA(0, 0), cA, voffA); PG8_STAGE(PG8_SA(0, 1), cA + hstep, voffA);
        if (wr == 1) PG8_BAR;
        PG8_WAIT_V(2); PG8_BAR;
        PG8_STAGE(PG8_SB(1, 0), cB + kstep, voffB); PG8_STAGE(PG8_SA(1, 0), cA + kstep, voffA); PG8_STAGE(PG8_SB(1, 1), cB + hstep + kstep, voffB);
        PG8_WAIT_V(6); PG8_BAR;
    } else {
        PG8_STAGE(PG8_SB(0, 0), cB, voffB); PG8_STAGE(PG8_SA(0, 0), cA, voffA); PG8_STAGE(PG8_SB(0, 1), cB + hstep, voffB); PG8_STAGE(PG8_SA(0, 1), cA + hstep, voffA);
        if (wr == 1) PG8_BAR;
        PG8_WAIT_V(4); PG8_BAR;
        PG8_STAGE(PG8_SB(1, 0), cB + kstep, voffB); PG8_STAGE(PG8_SA(1, 0), cA + kstep, voffA); PG8_STAGE(PG8_SB(1, 1), cB + hstep + kstep, voffB);
        PG8_WAIT_V(6); PG8_BAR;
    }
    for (;;) {
        const bool has_next = S.next(ui + 1, nxt);
        const char* nA = has_next ? (const char*)g.A + (size_t)nxt.pm * tstep : cA; const char* nB = has_next ? (const char*)g.Bt + (size_t)nxt.pn * tstep : cB;
        for (int t = 0; t < nt; t += 2) {
            const bool last = (t == nt - 2);
            const char* a1 = cA + (size_t)(t + 1) * kstep;
            const char* a2 = last ? nA : cA + (size_t)(t + 2) * kstep; const char* b2 = last ? nB : cB + (size_t)(t + 2) * kstep;
            const char* a3 = a2 + kstep; const char* b3 = b2 + kstep;
            if (last && has_next) S.a_ready(nxt);
            if constexpr (SP2) {
            PG8_LDB(B0, 0, 0); PG8_LDB(B1, 0, 1); PG8_SCHED; PG8_LDA(At, 0, 0); PG8_STAGE(PG8_SA(1, 1), a1 + hstep, voffA);
            PG8_WAIT_V(8); PG8_WAIT_L(0); PG8_BAR; PG8_MMA(0, 0, At, B0); PG8_MMA(0, 1, At, B1); PG8_BAR; PG8_SCHED;
            PG8_LDA(At, 0, 1); PG8_STAGE(PG8_SB(0, 0), b2, voffB); PG8_STAGE(PG8_SB(0, 1), b2 + hstep, voffB); PG8_STAGE(PG8_SA(0, 0), a2, voffA);
            PG8_WAIT_V(8); PG8_WAIT_L(0); PG8_BAR; PG8_MMA(1, 0, At, B0); PG8_MMA(1, 1, At, B1); PG8_BAR; PG8_SCHED;
            PG8_LDB(B0, 1, 0); PG8_LDB(B1, 1, 1); PG8_SCHED; PG8_LDA(At, 1, 0); PG8_STAGE(PG8_SA(0, 1), a2 + hstep, voffA);
            PG8_WAIT_V(8); PG8_WAIT_L(0); PG8_BAR; PG8_MMA(0, 0, At, B0); PG8_MMA(0, 1, At, B1); PG8_BAR; PG8_SCHED;
            PG8_LDA(At, 1, 1); PG8_STAGE(PG8_SB(1, 0), b3, voffB); PG8_STAGE(PG8_SB(1, 1), b3 + hstep, voffB); PG8_STAGE(PG8_SA(1, 0), a3, voffA);
            PG8_WAIT_V(8); PG8_WAIT_L(0); PG8_BAR; PG8_MMA(1, 0, At, B0); PG8_MMA(1, 1, At, B1); PG8_BAR; PG8_SCHED;
            } else {
            PG8_LDB(B0, 0, 0); PG8_SCHED; PG8_LDA(At, 0, 0); PG8_STAGE(PG8_SA(1, 1), a1 + hstep, voffA);
            PG8_WAIT_L(8); PG8_BAR; PG8_WAIT_L(0); PG8_MMA(0, 0, At, B0); PG8_BAR; PG8_SCHED;
            PG8_LDB(B1, 0, 1); PG8_STAGE(PG8_SB(0, 0), b2, voffB);
            PG8_BAR; PG8_WAIT_L(0); PG8_MMA(0, 1, At, B1); PG8_BAR;
            PG8_LDA(At, 0, 1); PG8_STAGE(PG8_SA(0, 0), a2, voffA);
            PG8_BAR; PG8_WAIT_L(0); PG8_MMA(1, 0, At, B0); PG8_BAR; PG8_SCHED;
            PG8_STAGE(PG8_SB(0, 1), b2 + hstep, voffB);
            PG8_WAIT_V(6); PG8_BAR; PG8_MMA(1, 1, At, B1); PG8_BAR;
            PG8_LDB(B0, 1, 0); PG8_SCHED; PG8_LDA(At, 1, 0); PG8_STAGE(PG8_SA(0, 1), a2 + hstep, voffA);
            PG8_WAIT_L(8); PG8_BAR; PG8_WAIT_L(0); PG8_MMA(0, 0, At, B0); PG8_BAR; PG8_SCHED;
            PG8_LDB(B1, 1, 1); PG8_STAGE(PG8_SB(1, 0), b3, voffB);
            PG8_BAR; PG8_WAIT_L(0); PG8_MMA(0, 1, At, B1); PG8_BAR;
            PG8_LDA(At, 1, 1); PG8_STAGE(PG8_SA(1, 0), a3, voffA);
            PG8_BAR; PG8_WAIT_L(0); PG8_MMA(1, 0, At, B0); PG8_BAR; PG8_SCHED;
            PG8_STAGE(PG8_SB(1, 1), b3 + hstep, voffB);
            PG8_WAIT_V(6); PG8_BAR; PG8_MMA(1, 1, At, B1); PG8_BAR;
            }
            if constexpr (Epi::HOOK) E.hook(acc, cur, t + 2, wr, wc, fr, fq);
        }
        if constexpr (ALIGN_EPI) { if (wr == 0) PG8_BAR; }
        if constexpr (!Epi::AFTER_DRAIN) { E(acc, cur, wr, wc, fr, fq); S.done(cur); }
        if (!has_next) break;
#pragma unroll
        for (int a = 0; a < 2; ++a)
#pragma unroll
            for (int b = 0; b < 2; ++b)
#pragma unroll
                for (int m = 0; m < 4; ++m)
#pragma unroll
                    for (int n = 0; n < 2; ++n) acc[a][b][m][n] = (f32x4){0.f, 0.f, 0.f, 0.f};
        cur = nxt; cA = nA; cB = nB; ++ui;
        if constexpr (ALIGN_EPI) { if (wr == 1) PG8_BAR; }
    }
    PG8_WAIT_V(0);
    if constexpr (!ALIGN_EPI) { if (wr == 0) PG8_BAR; }
    PG8_BAR;
    if constexpr (Epi::AFTER_DRAIN) { E.fused(acc, cur, wr, wc, fr, fq, lds, wid, lane); S.done(cur); }
#undef PG8_SA
#undef PG8_SB
#undef PG8_STAGE
#undef PG8_LDA
#undef PG8_LDB
#undef PG8_MMA
#undef PG8_WAIT_V
#undef PG8_WAIT_L
#undef PG8_BAR
#undef PG8_SCHED
}
}

#define LAS __attribute__((address_space(3)))
typedef unsigned short bf16;
typedef float f32x4 __attribute__((ext_vector_type(4)));
typedef short bf16x8 __attribute__((ext_vector_type(8)));
typedef unsigned v4u __attribute__((ext_vector_type(4)));
typedef unsigned v2u __attribute__((ext_vector_type(2)));

constexpr int NWAVES = 8, NTHREADS = 512;
constexpr int M = 12288, MCTX = 8192, DM = 1024, DFF = 2816, DIN = 5632;
constexpr int LDS_BYTES = 147456;
constexpr float LN_EPS = 1e-5f, RMS_EPS = 1e-5f;
constexpr size_t MiB = 1u << 20;
constexpr size_t WS_ROPE = 64 * 1024, WS_LAM = 80 * 1024, WS_MOD = 128 * 1024;
constexpr size_t WS_W = 1 * MiB;
constexpr size_t WL_W13A = 0, WL_W2A = 11 * MiB, WL_WIN = 16 * MiB + MiB / 2, WL_WP = 27 * MiB + MiB / 2, WL_WOUT = 29 * MiB + MiB / 2, WL_W13B = 31 * MiB + MiB / 2, WL_W2B = 42 * MiB + MiB / 2, WL_SIZE = 48 * MiB;
constexpr size_t WS_UZ = 97 * MiB;
constexpr size_t WS_XM = 229 * MiB;
constexpr size_t WS_MIX = 253 * MiB;
constexpr size_t WS_VT_CD = 277 * MiB, WS_VT_CN = 285 * MiB, WS_VT_LD = 289 * MiB, WS_VT_LN = 299 * MiB, WS_CK_D = 304 * MiB, WS_CK_N = 306 * MiB, WS_END = 307 * MiB;

struct Params {
    const float* in[31];
    float* out; unsigned char* ws;
    int ph_lo, ph_hi;
};
typedef const __attribute__((address_space(4))) Params& KP;
enum { I_XP = 0, I_XS, I_CDK, I_CDV, I_CNK, I_CNV, I_C, I_CCTX, I_WMOD, I_BMOD, I_LNG, I_LNB, I_F1W1, I_F1W3, I_F1W2, I_F2W1, I_F2W3, I_F2W2, I_WIN, I_POOLW, I_POOLS, I_WPA, I_WPB, I_WPC,
       I_LQ1, I_LK1, I_LQ2, I_LK2, I_SUBG, I_RPB, I_WOUT };

__device__ __forceinline__ unsigned f2bf(float f) { unsigned u = __builtin_bit_cast(unsigned, f); return (u + 0x7fffu + ((u >> 16) & 1u)) >> 16; }
__device__ __forceinline__ unsigned pk2(float lo, float hi) { return f2bf(lo) | (f2bf(hi) << 16); }
__device__ __forceinline__ float bf2f(unsigned short h) { return __uint_as_float((unsigned)h << 16); }
__device__ __forceinline__ float wave_sum(float v) {
#pragma unroll
    for (int o = 1; o < 64; o <<= 1) v += __shfl_xor(v, o);
    return v;
}

__device__ __forceinline__ void transpose_item(const float* W, int N, int k0, int n0, bf16* dst, int dpitch, LAS float* scr, int lane) {
#pragma unroll 8
    for (int i = 0; i < 32; ++i) { const int kk = 2 * i + (lane >> 5); scr[kk * 33 + (lane & 31)] = W[(size_t)(k0 + kk) * N + n0 + (lane & 31)]; }
    asm volatile("s_waitcnt lgkmcnt(0)" ::: "memory");
    const int c = lane & 7;
#pragma unroll
    for (int j = 0; j < 4; ++j) { const int n = (lane >> 3) + 8 * j; const LAS float* s = scr + (8 * c) * 33 + n;
        v4u o; o.x = pk2(s[0 * 33], s[1 * 33]); o.y = pk2(s[2 * 33], s[3 * 33]); o.z = pk2(s[4 * 33], s[5 * 33]); o.w = pk2(s[6 * 33], s[7 * 33]);
        *(v4u*)(dst + (size_t)n * dpitch + 8 * c) = o; }
    asm volatile("s_waitcnt lgkmcnt(0)" ::: "memory");
}

__device__ __forceinline__ void prologue_phase(KP P, LAS unsigned char* lds, int tid, int lane, int wave) {
    unsigned char* ws = P.ws;
    {
        LAS float* sc = (LAS float*)lds;
        LAS float* red = (LAS float*)(lds + 12288);
        for (int i = tid; i < 3072; i += NTHREADS) { const int ci = i >> 10, k = i & 1023; const float v = ci == 0 ? P.in[I_CCTX][k] : P.in[I_C][(ci - 1) * 1024 + k]; sc[i] = v / (1.0f + __expf(-v)); }
        __syncthreads();
        float* MOD = (float*)(ws + WS_MOD);
        const int cq = tid & 15, kg = tid >> 4;
        for (int u = blockIdx.x; u < 288; u += gridDim.x) {
            const int l = u / 144, jg = u % 144;
            const float* wp = P.in[I_WMOD] + (size_t)l * 1024 * 9216 + jg * 64 + 4 * cq;
            f32x4 a0 = {0.f, 0.f, 0.f, 0.f}, a1 = a0, a2 = a0;
#pragma unroll 4
            for (int i = 0; i < 32; ++i) { const int k = kg + 32 * i; const f32x4 w = *(const f32x4*)(wp + (size_t)k * 9216); a0 += w * sc[k]; a1 += w * sc[1024 + k]; a2 += w * sc[2048 + k]; }
#pragma unroll
            for (int e = 0; e < 4; ++e) { red[(kg * 3 + 0) * 64 + 4 * cq + e] = a0[e]; red[(kg * 3 + 1) * 64 + 4 * cq + e] = a1[e]; red[(kg * 3 + 2) * 64 + 4 * cq + e] = a2[e]; }
            __syncthreads();
            if (tid < 192) { const int ci = tid >> 6, j = tid & 63; float s = 0.f;
                for (int g = 0; g < 32; ++g) s += red[(g * 3 + ci) * 64 + j];
                MOD[(size_t)(ci * 2 + l) * 9216 + jg * 64 + j] = s + P.in[I_BMOD][l * 9216 + jg * 64 + j]; }
            __syncthreads();
        }
    }
    if (blockIdx.x == 0) {
        float* rope = (float*)(ws + WS_ROPE);
        for (int i = tid; i < 1024; i += NTHREADS) { const int pos = i >> 4, f = i & 15; const float inv = powf(10000.0f, -(float)f / 16.0f); const float ang = (float)pos * inv; rope[pos * 32 + f] = cosf(ang); rope[pos * 32 + 16 + f] = sinf(ang); }
        if (wave < 2) { const int l = wave; const float d1 = wave_sum(P.in[I_LQ1][l * 64 + lane] * P.in[I_LK1][l * 64 + lane]), d2 = wave_sum(P.in[I_LQ2][l * 64 + lane] * P.in[I_LK2][l * 64 + lane]);
            const float lam_init = 0.8f - 0.6f * expf(-0.3f * (float)l);
            if (lane == 0) { float* LAM = (float*)(ws + WS_LAM); LAM[l * 2] = expf(d1) - expf(d2) + lam_init; LAM[l * 2 + 1] = 1.0f - lam_init; } }
    }
    {
        const int gt = blockIdx.x * NTHREADS + tid, NT = gridDim.x * NTHREADS;
        bf16* ckd = (bf16*)(ws + WS_CK_D); bf16* ckn = (bf16*)(ws + WS_CK_N);
        for (int i = gt; i < 1048576 / 4; i += NT) { const f32x4 v = ((const f32x4*)P.in[I_CDK])[i]; v2u o; o.x = pk2(v[0], v[1]); o.y = pk2(v[2], v[3]); ((v2u*)ckd)[i] = o; }
        for (int i = gt; i < 524288 / 4; i += NT) { const f32x4 v = ((const f32x4*)P.in[I_CNK])[i]; v2u o; o.x = pk2(v[0], v[1]); o.y = pk2(v[2], v[3]); ((v2u*)ckn)[i] = o; }
        bf16* vld = (bf16*)(ws + WS_VT_LD); bf16* vln = (bf16*)(ws + WS_VT_LN);
        for (int i = gt; i < 1048576; i += NT) {
            const int key = i & 511, dv = (i >> 9) & 127, h = (i >> 16) & 3, bl = (i >> 18) & 1, l = i >> 19;
            const float v = P.in[I_CDV][((size_t)((bl * 2 + l) * 512 + key)) * 512 + h * 128 + dv];
            vld[((size_t)((l * 2 + bl) * 4 + h) * 128 + dv) * 2560 + 2048 + key] = (bf16)f2bf(v); }
        for (int i = gt; i < 524288; i += NT) {
            const int key = i & 511, dv = (i >> 9) & 63, h = (i >> 15) & 3, bl = (i >> 17) & 1, l = i >> 18;
            const float v = P.in[I_CNV][((size_t)((bl * 2 + l) * 512 + key)) * 256 + h * 64 + dv];
            vln[((size_t)((l * 2 + bl) * 4 + h) * 64 + dv) * 2560 + 2048 + key] = (bf16)f2bf(v); }
    }
    {
        LAS float* scr = (LAS float*)(lds + 40960 + wave * 8704);
        const int gw = blockIdx.x * NWAVES + wave, NGW = gridDim.x * NWAVES;
        for (int it = gw; it < 2 * 12288; it += NGW) {
            const int l = it / 12288; int r = it % 12288;
            bf16* wl = (bf16*)(ws + WS_W + (size_t)l * WL_SIZE);
            const float* src; int N, k0, n0; bf16* dst; int dp;
            if (r < 8448) {
                const int which = r / 1408, q = r % 1408; const int ffn = which / 3, mat = which % 3;
                if (mat < 2) { N = DFF; const int kb = q / 88, nb = q % 88; k0 = 64 * kb; n0 = 32 * nb;
                    src = P.in[(ffn ? I_F2W1 : I_F1W1) + mat] + (size_t)l * 1024 * DFF;
                    dst = (bf16*)((unsigned char*)wl + (ffn ? WL_W13B : WL_W13A)) + (size_t)((n0 >> 7) * 256 + (n0 & 127) + mat * 128) * 1024 + k0; dp = 1024; }
                else { N = 1024; const int kb = q / 32, nb = q % 32; k0 = 64 * kb; n0 = 32 * nb;
                    src = P.in[ffn ? I_F2W2 : I_F1W2] + (size_t)l * DFF * 1024;
                    dst = (bf16*)((unsigned char*)wl + (ffn ? WL_W2B : WL_W2A)) + (size_t)n0 * DFF + k0; dp = DFF; }
            } else { r -= 8448;
                if (r < 2816) { N = DIN; const int kb = r / 176, nb = r % 176; k0 = 64 * kb; n0 = 32 * nb; src = P.in[I_WIN] + (size_t)l * 1024 * DIN; dst = (bf16*)((unsigned char*)wl + WL_WIN) + (size_t)n0 * 1024 + k0; dp = 1024; }
                else { r -= 2816; N = 1024; const int kb = r / 32, nb = r % 32; n0 = 32 * nb; dp = 1024;
                    if (kb < 4) { k0 = 64 * kb; src = P.in[I_WPA] + (size_t)l * 256 * 1024; dst = (bf16*)((unsigned char*)wl + WL_WP) + (size_t)n0 * 1024 + k0; }
                    else if (kb < 12) { k0 = 64 * (kb - 4); src = P.in[I_WPB] + (size_t)l * 512 * 1024; dst = (bf16*)((unsigned char*)wl + WL_WP) + (size_t)n0 * 1024 + 256 + k0; }
                    else if (kb < 16) { k0 = 64 * (kb - 12); src = P.in[I_WPC] + (size_t)l * 256 * 1024; dst = (bf16*)((unsigned char*)wl + WL_WP) + (size_t)n0 * 1024 + 768 + k0; }
                    else { k0 = 64 * (kb - 16); src = P.in[I_WOUT] + (size_t)l * 1024 * 1024; dst = (bf16*)((unsigned char*)wl + WL_WOUT) + (size_t)n0 * 1024 + k0; } }
            }
            transpose_item(src, N, k0, n0, dst, dp, scr, lane);
        }
    }
}

__device__ __forceinline__ void ln_phase(KP P, int mode, int l, int i, int nl, int ni, int lane, int wave) {
    float* X = P.out; bf16* XM = (bf16*)(P.ws + WS_XM); const float* MOD = (const float*)(P.ws + WS_MOD);
    const int gw = blockIdx.x * NWAVES + wave, NGW = gridDim.x * NWAVES;
    for (int row = gw; row < M; row += NGW) {
        const int cond = row < MCTX ? 0 : 1 + ((row - MCTX) >> 11);
        const float* src = mode ? X + (size_t)row * DM : (row < MCTX ? P.in[I_XP] + (size_t)row * DM : P.in[I_XS] + (size_t)(row - MCTX) * DM);
        f32x4 v[4];
#pragma unroll
        for (int j = 0; j < 4; ++j) v[j] = ((const f32x4*)src)[lane + 64 * j];
        if (mode) {
            float s = 0.f;
#pragma unroll
            for (int j = 0; j < 4; ++j) s += (v[j][0] + v[j][1]) + (v[j][2] + v[j][3]);
            const float mean = wave_sum(s) * (1.0f / DM); float s2 = 0.f;
#pragma unroll
            for (int j = 0; j < 4; ++j) { v[j] = v[j] - mean; s2 += (v[j][0] * v[j][0] + v[j][1] * v[j][1]) + (v[j][2] * v[j][2] + v[j][3] * v[j][3]); }
            const float rstd = 1.0f / sqrtf(wave_sum(s2) * (1.0f / DM) + LN_EPS);
            const f32x4* g = (const f32x4*)(P.in[I_LNG] + (size_t)(l * 3 + i) * DM); const f32x4* b = (const f32x4*)(P.in[I_LNB] + (size_t)(l * 3 + i) * DM);
#pragma unroll
            for (int j = 0; j < 4; ++j) v[j] = v[j] * rstd * g[lane + 64 * j] + b[lane + 64 * j];
        }
#pragma unroll
        for (int j = 0; j < 4; ++j) ((f32x4*)(X + (size_t)row * DM))[lane + 64 * j] = v[j];
        if (ni >= 0) {
            const f32x4* sh = (const f32x4*)(MOD + (size_t)(cond * 2 + nl) * 9216 + (3 * ni) * DM); const f32x4* scl = (const f32x4*)(MOD + (size_t)(cond * 2 + nl) * 9216 + (3 * ni + 1) * DM);
#pragma unroll
            for (int j = 0; j < 4; ++j) { const f32x4 o = v[j] * (scl[lane + 64 * j] + 1.0f) + sh[lane + 64 * j]; v2u w; w.x = pk2(o[0], o[1]); w.y = pk2(o[2], o[3]);
                ((v2u*)(XM + (size_t)row * DM))[lane + 64 * j] = w; }
        }
    }
}

constexpr float kScaleLog2 = 0.125f * 1.44269504088896341f;
constexpr float kLog2e = 1.44269504088896341f;
template <int NMAP, int DV> struct AState { f32x4 o[NMAP][DV / 16]; float m[NMAP], l[NMAP]; };

template <int NMAP, int DV, bool NA>
__device__ __forceinline__ void attn_seg(AState<NMAP, DV>& st, const bf16x8 (&qf)[NMAP][2], const bf16* kl, int kstride, int nkeys, const bf16* vl, int vpitch,
                                         const float* rpb, int qr, int rs, int qcol, int fq) {
    const int cs = qcol - 8 < 0 ? 0 : (qcol - 8 > 48 ? 48 : qcol - 8);
    for (int c = 0; c < nkeys; c += 32) {
        f32x4 s[NMAP][2];
#pragma unroll
        for (int mp = 0; mp < NMAP; ++mp)
#pragma unroll
            for (int t2 = 0; t2 < 2; ++t2) { const bf16* kp = kl + (size_t)(c + 16 * t2) * kstride + mp * 64;
                const bf16x8 a0 = *(const bf16x8*)kp, a1 = *(const bf16x8*)(kp + 32);
                f32x4 z = {0.f, 0.f, 0.f, 0.f};
                z = __builtin_amdgcn_mfma_f32_16x16x32_bf16(a0, qf[mp][0], z, 0, 0, 0);
                s[mp][t2] = __builtin_amdgcn_mfma_f32_16x16x32_bf16(a1, qf[mp][1], z, 0, 0, 0); }
        bf16x8 pb[NMAP];
#pragma unroll
        for (int mp = 0; mp < NMAP; ++mp) {
            float sc[8];
#pragma unroll
            for (int t2 = 0; t2 < 2; ++t2)
#pragma unroll
                for (int r = 0; r < 4; ++r) {
                    float v = s[mp][t2][r] * kScaleLog2;
                    if (NA) { const int kk = c + 16 * t2 + 4 * fq + r, kc = kk & 63, dr = rs + (kk >> 6) - qr + 7; int dc = kc - qcol; dc = dc < -15 ? -15 : (dc > 15 ? 15 : dc);
                        const bool ok = kc >= cs && kc < cs + 16;
                        v = ok ? v + rpb[dr * 31 + dc + 15] * kLog2e : -1e30f; }
                    sc[t2 * 4 + r] = v; }
            float mx = fmaxf(fmaxf(fmaxf(sc[0], sc[1]), fmaxf(sc[2], sc[3])), fmaxf(fmaxf(sc[4], sc[5]), fmaxf(sc[6], sc[7])));
            mx = fmaxf(mx, __shfl_xor(mx, 16)); mx = fmaxf(mx, __shfl_xor(mx, 32));
            const float mnew = fmaxf(st.m[mp], mx), corr = exp2f(st.m[mp] - mnew); st.m[mp] = mnew;
            float p[8], rsum = 0.f;
#pragma unroll
            for (int e = 0; e < 8; ++e) { p[e] = exp2f(sc[e] - mnew); rsum += p[e]; }
            st.l[mp] = st.l[mp] * corr + rsum;
#pragma unroll
            for (int dt = 0; dt < DV / 16; ++dt) st.o[mp][dt] = st.o[mp][dt] * corr;
            v4u w; w.x = pk2(p[0], p[1]); w.y = pk2(p[2], p[3]); w.z = pk2(p[4], p[5]); w.w = pk2(p[6], p[7]);
            pb[mp] = __builtin_bit_cast(bf16x8, w);
        }
#pragma unroll
        for (int dt = 0; dt < DV / 16; ++dt) { const bf16* vp = vl + (size_t)(16 * dt) * vpitch + c;
            const v2u lo = *(const v2u*)vp, hi = *(const v2u*)(vp + 16); v4u w; w.x = lo.x; w.y = lo.y; w.z = hi.x; w.w = hi.y; const bf16x8 a = __builtin_bit_cast(bf16x8, w);
#pragma unroll
            for (int mp = 0; mp < NMAP; ++mp) st.o[mp][dt] = __builtin_amdgcn_mfma_f32_16x16x32_bf16(a, pb[mp], st.o[mp][dt], 0, 0, 0); }
    }
}
template <int NMAP, int DV> __device__ __forceinline__ void astate_init(AState<NMAP, DV>& st) {
#pragma unroll
    for (int mp = 0; mp < NMAP; ++mp) { st.m[mp] = -1e30f; st.l[mp] = 0.f;
#pragma unroll
        for (int dt = 0; dt < DV / 16; ++dt) st.o[mp][dt] = (f32x4){0.f, 0.f, 0.f, 0.f}; }
}
__device__ __forceinline__ void load_q(bf16x8 (&q)[2], const bf16* qp) { q[0] = *(const bf16x8*)qp; q[1] = *(const bf16x8*)(qp + 32); }

__device__ __forceinline__ void diff_unit(KP P, int l, const bf16* Z, int qrow0, int h, const bf16* kA, int kAstride, int nA, const bf16* kB, int kBstride, int nB,
                                          const bf16* vt, int vpitch, int lane) {
    const int fr = lane & 15, fq = lane >> 4;
    bf16x8 qf[2][2];
    const bf16* qp = Z + (size_t)(qrow0 + fr) * DIN + 256 + h * 128 + 8 * fq;
    load_q(qf[0], qp); load_q(qf[1], qp + 64);
    AState<2, 128> st; astate_init(st);
    attn_seg<2, 128, false>(st, qf, kA + (size_t)fr * kAstride + 8 * fq, kAstride, nA, vt + (size_t)fr * vpitch + 4 * fq, vpitch, nullptr, 0, 0, 0, fq);
    if (nB > 0) attn_seg<2, 128, false>(st, qf, kB + (size_t)fr * kBstride + 8 * fq, kBstride, nB, vt + (size_t)fr * vpitch + nA + 4 * fq, vpitch, nullptr, 0, 0, 0, fq);
    float l0 = st.l[0], l1 = st.l[1];
    l0 += __shfl_xor(l0, 16); l0 += __shfl_xor(l0, 32); l1 += __shfl_xor(l1, 16); l1 += __shfl_xor(l1, 32);
    const float* LAM = (const float*)(P.ws + WS_LAM);
    const float i0 = 1.0f / l0, i1 = LAM[l * 2] / l1, post = LAM[l * 2 + 1];
    float ss = 0.f;
#pragma unroll
    for (int dt = 0; dt < 8; ++dt) { const f32x4 v = st.o[0][dt] * i0 - st.o[1][dt] * i1; st.o[0][dt] = v; ss += (v[0] * v[0] + v[1] * v[1]) + (v[2] * v[2] + v[3] * v[3]); }
    ss += __shfl_xor(ss, 16); ss += __shfl_xor(ss, 32);
    const float rms = 1.0f / sqrtf(ss * (1.0f / 128.0f) + RMS_EPS) * post;
    bf16* yp = (bf16*)(P.ws + WS_XM) + (size_t)(qrow0 + fr) * DM + 256 + h * 128 + 4 * fq;
    const float* g = P.in[I_SUBG] + l * 128 + 4 * fq;
#pragma unroll
    for (int dt = 0; dt < 8; ++dt) { const f32x4 v = st.o[0][dt] * rms * *(const f32x4*)(g + 16 * dt); v2u w; w.x = pk2(v[0], v[1]); w.y = pk2(v[2], v[3]); *(v2u*)(yp + 16 * dt) = w; }
}

template <bool NA>
__device__ __forceinline__ void na_unit(KP P, const bf16* Z, int qrow0, int h, const bf16* kA, int kAstride, int nA, const bf16* vA, const bf16* kB, int kBstride, int nB, const bf16* vB,
                                        int vpitch, const float* rpb, int qr, int rs, int w0, int lane) {
    const int fr = lane & 15, fq = lane >> 4;
    bf16x8 qf[1][2];
    load_q(qf[0], Z + (size_t)(qrow0 + fr) * DIN + 1792 + h * 64 + 8 * fq);
    AState<1, 64> st; astate_init(st);
    attn_seg<1, 64, NA>(st, qf, kA + (size_t)fr * kAstride + 8 * fq, kAstride, nA, vA + (size_t)fr * vpitch + 4 * fq, vpitch, rpb, qr, rs, w0 + fr, fq);
    if (nB > 0) attn_seg<1, 64, false>(st, qf, kB + (size_t)fr * kBstride + 8 * fq, kBstride, nB, vB + (size_t)fr * vpitch + 4 * fq, vpitch, nullptr, 0, 0, 0, fq);
    float l0 = st.l[0]; l0 += __shfl_xor(l0, 16); l0 += __shfl_xor(l0, 32);
    const float i0 = 1.0f / l0;
    bf16* yp = (bf16*)(P.ws + WS_XM) + (size_t)(qrow0 + fr) * DM + 768 + h * 64 + 4 * fq;
#pragma unroll
    for (int dt = 0; dt < 4; ++dt) { const f32x4 v = st.o[0][dt] * i0; v2u w; w.x = pk2(v[0], v[1]); w.y = pk2(v[2], v[3]); *(v2u*)(yp + 16 * dt) = w; }
}

__device__ __forceinline__ void pool_unit(KP P, int l, const bf16* Z, int tok0, LAS unsigned char* lds, int tid) {
    LAS bf16* A = (LAS bf16*)lds;
    LAS float* PP = (LAS float*)(lds + 40960);
    const bool ctx = tok0 < MCTX; const int n = ctx ? 256 : 64; const int seg0 = ctx ? (tok0 & ~255) : tok0; const int t0 = tok0 - seg0;
    for (int i = tid; i < 80 * 32; i += NTHREADS) { const int rr = i >> 5, ch = i & 31; const int t = t0 - 8 + rr; v4u v = {0u, 0u, 0u, 0u};
        if (t >= 0 && t < n) v = *(const v4u*)(Z + (size_t)(seg0 + t) * DIN + 8 * ch);
        *(LAS v4u*)(A + rr * 256 + 8 * ch) = v; }
    __syncthreads();
    { const int c = tid & 255, half = tid >> 8, g = c >> 6, hw = 1 << g;
        for (int i = half * 32; i < half * 32 + 32; ++i) { const int t = t0 + i; const int lo = t - hw < 0 ? 0 : t - hw, hi = t + hw > n ? n : t + hw; float s = 0.f;
            for (int tt = lo; tt < hi; ++tt) s += bf2f(A[(tt - t0 + 8) * 256 + c]);
            PP[i * 256 + c] = s / (float)(hi - lo) - bf2f(A[(i + 8) * 256 + c]); } }
    __syncthreads();
    { const int gd = tid & 255, half = tid >> 8, g = gd >> 6, d = gd & 63;
        const float* w = P.in[I_POOLW] + (size_t)((l * 4 + g) * 64) * 64 + d;
        float acc[32];
#pragma unroll
        for (int i = 0; i < 32; ++i) acc[i] = 0.f;
        for (int c = 0; c < 64; c += 4) { const float w0 = w[(c + 0) * 64], w1 = w[(c + 1) * 64], w2 = w[(c + 2) * 64], w3 = w[(c + 3) * 64];
#pragma unroll
            for (int i = 0; i < 32; ++i) { const f32x4 pv = *(const LAS f32x4*)(PP + (half * 32 + i) * 256 + g * 64 + c); acc[i] += (pv[0] * w0 + pv[1] * w1) + (pv[2] * w2 + pv[3] * w3); } }
        const float scl = P.in[I_POOLS][l * 256 + gd];
        bf16* yp = (bf16*)(P.ws + WS_XM) + (size_t)(tok0 + half * 32) * DM + gd;
#pragma unroll
        for (int i = 0; i < 32; ++i) yp[(size_t)i * DM] = (bf16)f2bf(acc[i] * scl);
    }
    __syncthreads();
}

__device__ __forceinline__ void att_phase(KP P, int l, LAS unsigned char* lds, int tid, int lane, int wave) {
    const bf16* Z = (const bf16*)(P.ws + WS_UZ);
    for (int u = blockIdx.x; u < 960; u += gridDim.x) {
        if (u < 128) {
            const int bl = u >> 6, h = (u >> 4) & 3, qb = u & 15; const int row0 = MCTX + bl * 2048;
            diff_unit(P, l, Z, row0 + qb * 128 + wave * 16, h, Z + (size_t)row0 * DIN + 768 + h * 128, DIN, 2048,
                      (const bf16*)(P.ws + WS_CK_D) + (size_t)(bl * 2 + l) * 512 * 512 + h * 128, 512, 512,
                      (const bf16*)(P.ws + WS_VT_LD) + (size_t)((l * 2 + bl) * 4 + h) * 128 * 2560, 2560, lane);
        } else if (u < 384) {
            const int v = u - 128, b = v >> 3, h = (v >> 1) & 3, qb = v & 1; const int row0 = b * 256;
            diff_unit(P, l, Z, row0 + qb * 128 + wave * 16, h, Z + (size_t)row0 * DIN + 768 + h * 128, DIN, 256, nullptr, 0, 0,
                      (const bf16*)(P.ws + WS_VT_CD) + (size_t)(b * 4 + h) * 128 * 256, 256, lane);
        } else if (u < 512) {
            const int v = u - 384, bl = v >> 6, h = (v >> 4) & 3, rb = v & 15; const int row0 = MCTX + bl * 2048;
            const int qr = 2 * rb + (wave >> 2), w0 = (wave & 3) * 16; const int rs = qr - 4 < 0 ? 0 : (qr - 4 > 24 ? 24 : qr - 4);
            const bf16* vt = (const bf16*)(P.ws + WS_VT_LN) + (size_t)((l * 2 + bl) * 4 + h) * 64 * 2560;
            na_unit<true>(P, Z, row0 + qr * 64 + w0, h, Z + (size_t)(row0 + rs * 64) * DIN + 2048 + h * 64, DIN, 512, vt + rs * 64,
                          (const bf16*)(P.ws + WS_CK_N) + (size_t)(bl * 2 + l) * 512 * 256 + h * 64, 256, 512, vt + 2048, 2560,
                          P.in[I_RPB] + (size_t)(l * 4 + h) * 465, qr, rs, w0, lane);
        } else if (u < 768) {
            const int v = u - 512, b = v >> 3, h = (v >> 1) & 3, qb = v & 1; const int row0 = b * 256;
            na_unit<false>(P, Z, row0 + qb * 128 + wave * 16, h, Z + (size_t)row0 * DIN + 2048 + h * 64, DIN, 256, (const bf16*)(P.ws + WS_VT_CN) + (size_t)(b * 4 + h) * 64 * 256,
                           nullptr, 0, 0, nullptr, 256, nullptr, 0, 0, 0, lane);
        } else {
            pool_unit(P, l, Z, (u - 768) * 64, lds, tid);
        }
    }
}

typedef __attribute__((address_space(1))) unsigned gu32;
#define XB_TMO      128
#define XB_XCNT(j)  (256  + 64 * (j))
#define XB_XSUB(j)  (1280 + 64 * (j))
#define XB_XGEN(j)  (2304 + 64 * (j))
#define XB_TOP      3328
#define XB_TOPGEN   3392
#define XCD_BAR_WORDS 3456
#define XB_SPIN_CAP (1u << 18)

__device__ __forceinline__ unsigned xb_ld(unsigned* p)              { return __hip_atomic_load(p, __ATOMIC_RELAXED, __HIP_MEMORY_SCOPE_AGENT); }
__device__ __forceinline__ unsigned xb_add(unsigned* p, unsigned v) { return __hip_atomic_fetch_add(p, v, __ATOMIC_RELAXED, __HIP_MEMORY_SCOPE_AGENT); }
__device__ __forceinline__ unsigned xb_xcc_id() { return (unsigned)__builtin_amdgcn_s_getreg((3 << 11) | 20) & 0xFu; }
#define XB_SPIN(cond, bar) do { unsigned _sp = 0; while (cond) { __builtin_amdgcn_s_sleep(1); \
    if ((++_sp & 255u) == 0u) { if (xb_ld(&(bar)[XB_TMO])) break; if (_sp > XB_SPIN_CAP) { atomicAdd(&(bar)[XB_TMO], 1u); break; } } } } while (0)

struct XcdBarrier {
    unsigned* bar; unsigned x;
    volatile LAS unsigned* st;
};

__device__ __forceinline__ XcdBarrier xcd_barrier_post(unsigned* bar, volatile LAS unsigned* st) {
    XcdBarrier b; b.bar = bar; b.x = xb_xcc_id(); b.st = st;
    if (threadIdx.x == 0) (void)xb_add(&bar[XB_XCNT(b.x)], 1u);
    return b;
}
__device__ __forceinline__ void xcd_barrier_complete(unsigned* bar, unsigned x, unsigned& nloc, unsigned& nx) {
    const unsigned G = gridDim.x * gridDim.y * gridDim.z;
    unsigned sum, cnt, mine, sp = 0u;
    for (;;) {
        sum = 0u; cnt = 0u; mine = 0u;
#pragma unroll
        for (unsigned j = 0; j < 16; ++j) { const unsigned c = xb_ld(&bar[XB_XCNT(j)]); sum += c; cnt += (c > 0u) ? 1u : 0u; mine = (j == x) ? c : mine; }
        if (sum == G) break;
        __builtin_amdgcn_s_sleep(1);
        if ((++sp & 255u) == 0u) { if (xb_ld(&bar[XB_TMO])) break; if (sp > XB_SPIN_CAP) { atomicAdd(&bar[XB_TMO], 1u); break; } }
    }
    nloc = mine > 0u ? mine : 1u; nx = cnt > 0u ? cnt : 1u;
}

__device__ __forceinline__ void xcd_barrier(const XcdBarrier& b) {
    asm volatile("s_waitcnt vmcnt(0)" ::: "memory");
    __syncthreads();
    if (threadIdx.x == 0) {
        unsigned* bar = b.bar;
        __builtin_amdgcn_s_waitcnt(0);
        unsigned nloc = b.st[0], nx = b.st[1];
        if (nloc == 0u) { xcd_barrier_complete(bar, b.x, nloc, nx); b.st[0] = nloc; b.st[1] = nx; }
        const unsigned old = xb_add(&bar[XB_XSUB(b.x)], 1u);
        const unsigned gen = old / nloc;
        if (old + 1u == (gen + 1u) * nloc) {
            __builtin_amdgcn_fence(__ATOMIC_RELEASE, "agent");
            asm volatile("s_waitcnt vmcnt(0)" ::: "memory");
            const unsigned og = xb_add(&bar[XB_TOP], 1u);
            const unsigned tg = og / nx;
            if (og + 1u == (tg + 1u) * nx) xb_add(&bar[XB_TOPGEN], 1u);
            else XB_SPIN(xb_ld(&bar[XB_TOPGEN]) == tg, bar);
            __builtin_amdgcn_fence(__ATOMIC_ACQUIRE, "agent");
            xb_add(&bar[XB_XGEN(b.x)], 1u);
            asm volatile("s_waitcnt vmcnt(0)" ::: "memory");
        } else {
            XB_SPIN(xb_ld(&bar[XB_XGEN(b.x)]) == gen, bar);
            __builtin_amdgcn_fence(__ATOMIC_ACQUIRE, "agent");
            asm volatile("s_waitcnt vmcnt(0)" ::: "memory");
        }
    }
    __syncthreads();
}

constexpr int N_PHASES = 24;
__global__ void __launch_bounds__(NTHREADS, 2) fwd_kernel(Params P0) {
    extern __shared__ __attribute__((aligned(16))) unsigned char lds_raw[];
    LAS unsigned char* lds = (LAS unsigned char*)lds_raw;
    cg::grid_group grid = cg::this_grid();
    if (threadIdx.x < 32) ((LAS unsigned*)(lds + 131072 + 320))[threadIdx.x] = 0u;
    __syncthreads();
    const XcdBarrier bar = xcd_barrier_post((unsigned*)P0.ws, (volatile LAS unsigned*)(lds + 131072 + 320) + 8);
    const int ph_lo = P0.ph_lo, ph_hi = P0.ph_hi;
    for (int ph = ph_lo; ph < ph_hi; ++ph) {
        const __attribute__((address_space(4))) Params* kp = (const __attribute__((address_space(4))) Params*)__builtin_amdgcn_kernarg_segment_ptr();
        asm volatile("" : "+s"(kp));
        KP P = *kp;
        unsigned char* ws = P.ws;
        int tid = threadIdx.x; asm volatile("" : "+v"(tid));
        const int lane = tid & 63, wave = __builtin_amdgcn_readfirstlane(tid >> 6);
#ifndef NO_PRO
        if (ph == 0) prologue_phase(P, lds, tid, lane, wave);
#else
        if (ph == 0) {}
#endif
        else if (ph == 1) ln_phase(P, 0, 0, 0, 0, 0, lane, wave);
        else {
            const int q = ph - 2, l = q / 11, s = q % 11;
            unsigned char* wl = ws + WS_W + (size_t)l * WL_SIZE;
            if (s == 0 || s == 8) {
                pg8::Gemm g{(const pg8::bf16_t*)(ws + WS_XM), (const pg8::bf16_t*)(wl + (s == 0 ? WL_W13A : WL_W13B)), M, DIN, DM}; pg8::StaticOrder S; S.init(M, DIN, gridDim.x, blockIdx.x);
                pg8::EpiSwiglu E{(pg8::bf16_t*)(ws + WS_UZ), DFF};
#ifndef NO_G1
                pg8::gemm_phase<pg8::EpiSwiglu, pg8::StaticOrder, true, true>(lds, g, S, E, tid);
#endif
            } else if (s == 1 || s == 6 || s == 9) {
                const pg8::bf16_t* A = (const pg8::bf16_t*)(ws + (s == 6 ? WS_MIX : WS_UZ)); const pg8::bf16_t* B = (const pg8::bf16_t*)(wl + (s == 1 ? WL_W2A : (s == 6 ? WL_WOUT : WL_W2B)));
                pg8::Gemm g{A, B, M, DM, s == 6 ? DM : DFF}; pg8::StaticOrder S; S.init(M, DM, gridDim.x, blockIdx.x);
                pg8::EpiResid E{P.out, (const float*)(ws + WS_MOD), l, s == 1 ? 2 : (s == 6 ? 5 : 8), s == 6 ? 1.0f : 0.5f};
#ifndef NO_G2
                pg8::gemm_phase<pg8::EpiResid, pg8::StaticOrder, true, true>(lds, g, S, E, tid);
#endif
            } else if (s == 2 || s == 7 || s == 10) {
                const int i = s == 2 ? 0 : (s == 7 ? 1 : 2);
                int nl = l, ni = i + 1; if (i == 2) { nl = l + 1; ni = nl < 2 ? 0 : -1; }
                ln_phase(P, 1, l, i, nl, ni, lane, wave);
            } else if (s == 3) {
                pg8::Gemm g{(const pg8::bf16_t*)(ws + WS_XM), (const pg8::bf16_t*)(wl + WL_WIN), M, DIN, DM}; pg8::StaticOrder S; S.init(M, DIN, gridDim.x, blockIdx.x);
                pg8::EpiZ E{(pg8::bf16_t*)(ws + WS_UZ), P.out, (const float*)(ws + WS_ROPE), l, (pg8::bf16_t*)(ws + WS_VT_CD), (pg8::bf16_t*)(ws + WS_VT_CN), (pg8::bf16_t*)(ws + WS_VT_LD), (pg8::bf16_t*)(ws + WS_VT_LN)};
#ifndef NO_G3
                pg8::gemm_phase<pg8::EpiZ, pg8::StaticOrder, true, true>(lds, g, S, E, tid);
#endif
            } else if (s == 4) {
#ifndef NO_ATT
                att_phase(P, l, lds, tid, lane, wave);
#if PROBE_ATT
                __syncthreads(); att_phase(P, l, lds, tid, lane, wave);
#endif
#endif
            } else {
                pg8::Gemm g{(const pg8::bf16_t*)(ws + WS_XM), (const pg8::bf16_t*)(wl + WL_WP), M, DM, DM}; pg8::StaticOrder S; S.init(M, DM, gridDim.x, blockIdx.x);
                pg8::EpiMerge E{(const pg8::bf16_t*)(ws + WS_UZ), (pg8::bf16_t*)(ws + WS_MIX)};
#ifndef NO_G4
                pg8::gemm_phase<pg8::EpiMerge, pg8::StaticOrder, true, true>(lds, g, S, E, tid);
#endif
            }
        }
        if (ph + 1 < ph_hi) { if (ph == 0) grid.sync(); else xcd_barrier(bar); }
#if PROBE_SYNC
        if (ph + 1 < ph_hi) xcd_barrier(bar);
#endif
    }
}

#ifndef MK_PER_PHASE
#define MK_PER_PHASE 0
#endif
extern "C" void kernel_launch(void* const* d_in, const int* in_sizes, int n_in, void* d_out, int out_size, void* d_ws, size_t ws_size, hipStream_t stream) {
    static int grid = 0;
    if (grid == 0) {
        if (n_in != 31 || ws_size < WS_END) { fprintf(stderr, "kernel_launch: need 31 inputs and %zu bytes of workspace (got %d, %zu)\n", (size_t)WS_END, n_in, ws_size); grid = -1; return; }
        int dev = 0, cus = 0, per_cu = 0;
        hipGetDevice(&dev); hipDeviceGetAttribute(&cus, hipDeviceAttributeMultiprocessorCount, dev);
        if (hipFuncSetAttribute((const void*)fwd_kernel, hipFuncAttributeMaxDynamicSharedMemorySize, LDS_BYTES) != hipSuccess) { fprintf(stderr, "kernel_launch: hipFuncSetAttribute failed\n"); grid = -1; return; }
        if (hipOccupancyMaxActiveBlocksPerMultiprocessor(&per_cu, (const void*)fwd_kernel, NTHREADS, LDS_BYTES) != hipSuccess || per_cu < 1) { fprintf(stderr, "kernel_launch: occupancy query says %d\n", per_cu); per_cu = 1; }
        (void)hipGetLastError();
        grid = cus * 1;
        fprintf(stderr, "kernel_launch: grid %d (cus %d, per_cu %d)\n", grid, cus, per_cu);
    }
    if (grid < 0) return;
    if (hipMemsetAsync(d_ws, 0, 65536, stream) != hipSuccess) { fprintf(stderr, "kernel_launch: memset failed\n"); return; }
    Params p{};
    for (int i = 0; i < 31; ++i) p.in[i] = (const float*)d_in[i];
    p.out = (float*)d_out; p.ws = (unsigned char*)d_ws;
#if MK_PER_PHASE
    for (int ph = 0; ph < N_PHASES; ++ph) { p.ph_lo = ph; p.ph_hi = ph + 1; hipLaunchKernelGGL(fwd_kernel, dim3(grid), dim3(NTHREADS), LDS_BYTES, stream, p); }
#else
    p.ph_lo = 0; p.ph_hi = N_PHASES;
    void* args[] = {&p};
    const hipError_t e = hipLaunchCooperativeKernel((const void*)fwd_kernel, dim3(grid), dim3(NTHREADS), args, LDS_BYTES, stream);
    if (e != hipSuccess) fprintf(stderr, "kernel_launch: cooperative launch failed: %s (grid %d)\n", hipGetErrorString(e), grid);
#endif
}
```

```cpp
#ifndef PROBE_SYNC
#define PROBE_SYNC 0
#endif
#ifndef PROBE_ATT
#define PROBE_ATT 0
#endif
#include <hip/hip_runtime.h>
#include <hip/hip_cooperative_groups.h>
#include <cstdio>
#include <cstdint>
namespace cg = cooperative_groups;
constexpr size_t MiB = 1u << 20;
constexpr size_t WS_ROPE = 64 * 1024, WS_LAM = 80 * 1024, WS_MOD = 128 * 1024;
constexpr size_t WS_W = 1 * MiB;
constexpr size_t WL_W13A = 0, WL_W2A = 11 * MiB, WL_WIN = 16 * MiB + MiB / 2, WL_WP = 27 * MiB + MiB / 2, WL_WOUT = 29 * MiB + MiB / 2, WL_W13B = 31 * MiB + MiB / 2, WL_W2B = 42 * MiB + MiB / 2, WL_SIZE = 48 * MiB;
constexpr size_t WS_UZ = 97 * MiB;
constexpr size_t WS_XM = 193 * MiB;
constexpr size_t WS_MIX = 217 * MiB;
constexpr size_t WS_VT_CD = 241 * MiB, WS_VT_CN = 249 * MiB, WS_VT_LD = 253 * MiB, WS_VT_LN = 263 * MiB;
constexpr size_t WS_KC_LD = 268 * MiB, WS_KC_LN = 278 * MiB, WS_KC_CD = 283 * MiB, WS_KC_CN = 291 * MiB, WS_END = 295 * MiB;
constexpr int ZP = 4096;

namespace pg8 {
#define PG8_LAS __attribute__((address_space(3)))
typedef unsigned short bf16_t;
typedef short bf16x8 __attribute__((ext_vector_type(8)));
typedef float f32x4 __attribute__((ext_vector_type(4)));
typedef unsigned u32x4 __attribute__((ext_vector_type(4)));
constexpr int BM = 256, BK = 64, HALF = 128, HTB = HALF * BK * 2  , STAGE_BYTES = 8 * HTB, NXCD = 8, WGM = 8;

__host__ __device__ __forceinline__ int lds_byte(int r, int c) { const int st = (r >> 4) * 2 + (c >> 5), rr = r & 15, cc = c & 31, ob = rr * 64 + cc * 2; return st * 1024 + (ob ^ (((ob >> 9) & 1) << 5)); }
__host__ __device__ __forceinline__ void stage_rc(int b, int& R, int& C) { const int st = b / 1024, sb = b % 1024, swz = sb ^ (((sb >> 9) & 1) << 5); R = (st >> 1) * 16 + swz / 64; C = (st & 1) * 32 + (swz % 64) / 2; }
__host__ __device__ __forceinline__ int perm32(int rho) { const int n = rho >> 4, i = rho & 15; return 8 * (i >> 2) + 4 * n + (i & 3); }

struct Unit { int pm, pn; };
struct Gemm { const bf16_t* A; const bf16_t* Bt; int M, N, K; };

struct StaticOrder {
    int nM, nN, nwg, G, c;
    __host__ __device__ void init(int M, int N, int G_, int c_) { nM = M / BM; nN = N / BM; nwg = nM * nN; G = G_; c = c_; }
    __host__ __device__ bool next(int i, Unit& u) const {
        const long L = (long)i * G + c; if (L >= nwg) return false;
        int wgid = (int)L; { const int q = nwg / NXCD, r = nwg % NXCD, xcd = wgid % NXCD, off = wgid / NXCD; wgid = (xcd < r ? xcd * (q + 1) : r * (q + 1) + (xcd - r) * q) + off; }
        const int nig = WGM * nN, gid = wgid / nig, fm = gid * WGM, gsz = (nM - fm) < WGM ? (nM - fm) : WGM;
        u.pm = fm + ((wgid % nig) % gsz); u.pn = (wgid % nig) / gsz; return true;
    }
    __device__ __forceinline__ void a_ready(const Unit&) const {}
    __device__ __forceinline__ void done(const Unit&) const {}
};


__device__ __forceinline__ unsigned cvt_pk_bf16(float lo, float hi) { unsigned r; asm volatile("v_cvt_pk_bf16_f32 %0, %1, %2" : "=v"(r) : "v"(lo), "v"(hi)); return r; }
typedef unsigned u32x2 __attribute__((ext_vector_type(2)));
__device__ __forceinline__ float sigmoidf_(float x) { return 1.0f / (1.0f + __expf(-x)); }

constexpr float kAlpha = 1.41421356237309515f;

struct EpiSwiglu {
    static constexpr bool PERM = false, AFTER_DRAIN = false, HOOK = false;
    bf16_t* U; int ldu;
    __device__ __forceinline__ void hook(f32x4 (&)[2][2][4][2], const Unit&, int, int, int, int, int) const {}
    __device__ __forceinline__ void operator()(const f32x4 (&acc)[2][2][4][2], const Unit& u, int wr, int wc, int fr, int fq) const {
        int row0 = u.pm * BM + wr * 64 + fr, col0 = u.pn * 128 + wc * 32 + 4 * fq; asm volatile("" : "+v"(row0), "+v"(col0));
#pragma unroll
        for (int ai = 0; ai < 2; ++ai)
#pragma unroll
            for (int m = 0; m < 4; ++m) { bf16_t* rowp = U + (size_t)(row0 + ai * HALF + m * 16) * ldu + col0;
#pragma unroll
                for (int n = 0; n < 2; ++n) { const f32x4 a = acc[ai][0][m][n], b = acc[ai][1][m][n]; float v[4];
#pragma unroll
                    for (int j = 0; j < 4; ++j) v[j] = a[j] * sigmoidf_(a[j]) * b[j];
                    u32x2 w; w.x = cvt_pk_bf16(v[0], v[1]); w.y = cvt_pk_bf16(v[2], v[3]); *(u32x2*)(rowp + 16 * n) = w; } }
    }
};

struct EpiResid {
    static constexpr bool PERM = false, AFTER_DRAIN = false, HOOK = false;
    float* X; const float* mod; int l, gi; float s;
    __device__ __forceinline__ void hook(f32x4 (&)[2][2][4][2], const Unit&, int, int, int, int, int) const {}
    __device__ __forceinline__ void operator()(const f32x4 (&acc)[2][2][4][2], const Unit& u, int wr, int wc, int fr, int fq) const {
        int row0 = u.pm * BM + wr * 64 + fr, col0 = u.pn * BM + wc * 32 + 4 * fq; asm volatile("" : "+v"(row0), "+v"(col0));
        const int cond = u.pm < 32 ? 0 : 1 + ((u.pm - 32) >> 3);
        const float* gate = mod + (size_t)(cond * 2 + l) * 9216 + gi * 1024 + col0;
#pragma unroll
        for (int bj = 0; bj < 2; ++bj)
#pragma unroll
            for (int n = 0; n < 2; ++n) { const f32x4 g4 = *(const f32x4*)(gate + bj * HALF + n * 16) * s;
#pragma unroll
                for (int ai = 0; ai < 2; ++ai)
#pragma unroll
                    for (int m = 0; m < 4; ++m) { float* p = X + (size_t)(row0 + ai * HALF + m * 16) * 1024 + col0 + bj * HALF + n * 16;
                        const f32x4 x = *(const f32x4*)p; *(f32x4*)p = x * kAlpha + g4 * acc[ai][bj][m][n]; } }
    }
};

struct EpiZ {
    static constexpr bool PERM = false, AFTER_DRAIN = false, HOOK = false;
    unsigned char* ws; float* out; int l;
    __device__ __forceinline__ void hook(f32x4 (&)[2][2][4][2], const Unit&, int, int, int, int, int) const {}
    __device__ __forceinline__ void operator()(const f32x4 (&acc)[2][2][4][2], const Unit& u, int wr, int wc, int fr, int fq) const {
        const int pn = u.pn, pm = u.pm; const bool ctx = pm < 32;
        bf16_t* const Z = (bf16_t*)(ws + WS_UZ); const float* const rope = (const float*)(ws + WS_ROPE);
        bf16_t* const vt_cd = (bf16_t*)(ws + WS_VT_CD); bf16_t* const vt_cn = (bf16_t*)(ws + WS_VT_CN); bf16_t* const vt_ld = (bf16_t*)(ws + WS_VT_LD); bf16_t* const vt_ln = (bf16_t*)(ws + WS_VT_LN);
        bf16_t* const kc_cd = (bf16_t*)(ws + WS_KC_CD); bf16_t* const kc_cn = (bf16_t*)(ws + WS_KC_CN); bf16_t* const kc_ld = (bf16_t*)(ws + WS_KC_LD); bf16_t* const kc_ln = (bf16_t*)(ws + WS_KC_LN);
        int rt0 = wr * 64 + fr;
        int ct0 = wc * 32 + 4 * fq;
        asm volatile("" : "+v"(rt0), "+v"(ct0));
        const int bl = (pm - 32) >> 3, t0 = ctx ? 0 : ((pm - 32) & 7) * 256, nk = ctx ? 256 : 2560, hb = ctx ? pm * 4 : (l * 2 + bl) * 4;
        if (pn == 5 || pn == 6 || pn == 9) {
            const bool diff = pn != 9; const int DV = diff ? 128 : 64;
            bf16_t* vt = ctx ? (diff ? vt_cd : vt_cn) : (diff ? vt_ld : vt_ln);
#pragma unroll
            for (int bj = 0; bj < 2; ++bj)
#pragma unroll
                for (int n = 0; n < 2; ++n) {
                    int h, dv;
                    if (diff) { h = 2 * (pn - 5) + bj; dv = ct0 + 16 * n; } else { h = 2 * bj + (wc >> 1); dv = (wc & 1) * 32 + 4 * fq + 16 * n; }
                    bf16_t* vb = vt + (size_t)(hb + h) * DV * nk + dv * 32;
#pragma unroll
                    for (int ai = 0; ai < 2; ++ai)
#pragma unroll
                        for (int m = 0; m < 4; ++m) { const f32x4 a = acc[ai][bj][m][n]; const unsigned w0 = cvt_pk_bf16(a[0], a[1]), w1 = cvt_pk_bf16(a[2], a[3]);
                            const int t = t0 + rt0 + ai * HALF + m * 16; bf16_t* p = vb + (size_t)(t >> 5) * (DV * 32) + (t & 31);
                            p[0] = (bf16_t)(w0 & 0xffffu); p[32] = (bf16_t)(w0 >> 16); p[64] = (bf16_t)(w1 & 0xffffu); p[96] = (bf16_t)(w1 >> 16); asm volatile("" ::: "memory"); }
                }
            if (ctx) {
                float* ob = diff ? out + 20971520 + ((size_t)(pm * 2 + l) * 256) * 512 + (pn - 5) * 256 : out + 33554432 + ((size_t)(pm * 2 + l) * 256) * 256;
                const int ld = diff ? 512 : 256;
#pragma unroll
                for (int ai = 0; ai < 2; ++ai)
#pragma unroll
                    for (int m = 0; m < 4; ++m) { float* rowp = ob + (size_t)(rt0 + ai * HALF + m * 16) * ld + ct0;
#pragma unroll
                        for (int bj = 0; bj < 2; ++bj)
#pragma unroll
                            for (int n = 0; n < 2; ++n) *(f32x4*)(rowp + bj * HALF + n * 16) = acc[ai][bj][m][n];
                        asm volatile("" ::: "memory"); }
            }
            return;
        }
        const bool isk = pn == 3 || pn == 4 || pn == 8, gates = pn >= 10;
        bf16_t* base0; bf16_t* base1; int rs;
        if (!isk) { rs = 4096; const int zc = pn == 0 ? 0 : (pn <= 2 ? pn * 256 : (pn == 7 ? 768 : 1024 + (pn - 10) * 256));
            base0 = Z + (size_t)(pm * BM) * 4096 + zc + ct0; base1 = base0 + HALF; }
        else { rs = 64; const int d0 = (wc & 1) * 32 + 4 * fq;
            if (pn != 8) { bf16_t* kc = ctx ? kc_cd : kc_ld;
                base0 = kc + ((size_t)((hb + 2 * (pn - 3) + 0) * 2 + (wc >> 1)) * nk + t0) * 64 + d0; base1 = kc + ((size_t)((hb + 2 * (pn - 3) + 1) * 2 + (wc >> 1)) * nk + t0) * 64 + d0; }
            else { bf16_t* kc = ctx ? kc_cn : kc_ln;
                base0 = kc + ((size_t)(hb + (wc >> 1)) * nk + t0) * 64 + d0; base1 = kc + ((size_t)(hb + 2 + (wc >> 1)) * nk + t0) * 64 + d0; } }
        const bool do_rope = !ctx && pn >= 1 && pn <= 4;
        const int trow = ((pm - 32) & 7) * 4 + wr;
#pragma unroll
        for (int ai = 0; ai < 2; ++ai)
#pragma unroll
            for (int m = 0; m < 4; ++m) {
                const size_t ro = (size_t)(rt0 + ai * HALF + m * 16) * rs;
                f32x4 c4 = {1.f, 1.f, 1.f, 1.f}, s4 = {0.f, 0.f, 0.f, 0.f};
                if (do_rope) { const int pos = (wc & 1) ? (m * 16 + fr) : (trow + 2 * ai); const float* rp = rope + pos * 32 + 4 * fq; c4 = *(const f32x4*)rp; s4 = *(const f32x4*)(rp + 16); }
#pragma unroll
                for (int bj = 0; bj < 2; ++bj) {
                    const f32x4 x1 = acc[ai][bj][m][0], x2 = acc[ai][bj][m][1];
                    f32x4 o1 = x1 * c4 - x2 * s4, o2 = x1 * s4 + x2 * c4;
                    if (gates) {
#pragma unroll
                        for (int j = 0; j < 4; ++j) { o1[j] = sigmoidf_(o1[j]); o2[j] = sigmoidf_(o2[j]); } }
                    u32x2 w; w.x = cvt_pk_bf16(o1[0], o1[1]); w.y = cvt_pk_bf16(o1[2], o1[3]); *(u32x2*)((bj ? base1 : base0) + ro) = w;
                    w.x = cvt_pk_bf16(o2[0], o2[1]); w.y = cvt_pk_bf16(o2[2], o2[3]); *(u32x2*)((bj ? base1 : base0) + ro + 16) = w; }
                asm volatile("" ::: "memory");
            }
        if (ctx && isk) {
            float* ob = pn == 8 ? out + 29360128 + ((size_t)(pm * 2 + l) * 256) * 256 : out + 12582912 + ((size_t)(pm * 2 + l) * 256) * 512 + (pn - 3) * 256;
            const int ld = pn == 8 ? 256 : 512;
#pragma unroll
            for (int ai = 0; ai < 2; ++ai)
#pragma unroll
                for (int m = 0; m < 4; ++m) { float* rowp = ob + (size_t)(rt0 + ai * HALF + m * 16) * ld + ct0;
#pragma unroll
                    for (int bj = 0; bj < 2; ++bj)
#pragma unroll
                        for (int n = 0; n < 2; ++n) *(f32x4*)(rowp + bj * HALF + n * 16) = acc[ai][bj][m][n];
                    asm volatile("" ::: "memory"); }
        }
    }
};

struct EpiMerge {
    static constexpr bool PERM = false, AFTER_DRAIN = false, HOOK = true;
    const bf16_t* Z; bf16_t* MIX;
    __device__ __forceinline__ static f32x4 gate4(const bf16_t* p) { const u32x2 w = *(const u32x2*)p; f32x4 g;
        g[0] = __uint_as_float(w.x << 16); g[1] = __uint_as_float(w.x & 0xffff0000u); g[2] = __uint_as_float(w.y << 16); g[3] = __uint_as_float(w.y & 0xffff0000u);
#pragma unroll
        for (int j = 0; j < 4; ++j) g[j] = fmaxf(g[j], 1e-18f);
        return g; }
    __device__ __forceinline__ void hook(f32x4 (&acc)[2][2][4][2], const Unit& u, int tn, int wr, int wc, int fr, int fq) const {
        if (tn != 4 && tn != 12) return;
        const int s = tn == 4 ? 0 : 1;
        int row0 = u.pm * BM + wr * 64 + fr, col0 = u.pn * BM + wc * 32 + 4 * fq; asm volatile("" : "+v"(row0), "+v"(col0));
#pragma unroll
        for (int ai = 0; ai < 2; ++ai)
#pragma unroll
            for (int m = 0; m < 4; ++m) { const bf16_t* gp = Z + (size_t)(row0 + ai * HALF + m * 16) * 4096 + 1024 + s * 1024 + col0;
#pragma unroll
                for (int bj = 0; bj < 2; ++bj)
#pragma unroll
                    for (int n = 0; n < 2; ++n) { const f32x4 ga = gate4(gp + bj * HALF + n * 16), gb = gate4(gp + 1024 + bj * HALF + n * 16); f32x4 r;
#pragma unroll
                        for (int j = 0; j < 4; ++j) r[j] = ga[j] / gb[j];
                        acc[ai][bj][m][n] = acc[ai][bj][m][n] * r; asm volatile("" ::: "memory"); }
                }
    }
    __device__ __forceinline__ void operator()(const f32x4 (&acc)[2][2][4][2], const Unit& u, int wr, int wc, int fr, int fq) const {
        int row0 = u.pm * BM + wr * 64 + fr, col0 = u.pn * BM + wc * 32 + 4 * fq; asm volatile("" : "+v"(row0), "+v"(col0));
#pragma unroll
        for (int ai = 0; ai < 2; ++ai)
#pragma unroll
            for (int m = 0; m < 4; ++m) { const size_t r = (size_t)(row0 + ai * HALF + m * 16); const bf16_t* gp = Z + r * 4096 + 1024 + 2048 + col0; bf16_t* op = MIX + r * 1024 + col0;
#pragma unroll
                for (int bj = 0; bj < 2; ++bj)
#pragma unroll
                    for (int n = 0; n < 2; ++n) { const f32x4 v = acc[ai][bj][m][n] * gate4(gp + bj * HALF + n * 16); u32x2 w; w.x = cvt_pk_bf16(v[0], v[1]); w.y = cvt_pk_bf16(v[2], v[3]);
                        *(u32x2*)(op + bj * HALF + n * 16) = w; }
                asm volatile("" ::: "memory"); }
    }
};

template <class Epi, class Sched, bool ALIGN_EPI = false, bool SP2 = false>
__device__ __forceinline__ void gemm_phase(PG8_LAS unsigned char* lds, const Gemm g, const Sched& S, const Epi& E, const int tid_in) {
    const int tid = tid_in, wid = __builtin_amdgcn_readfirstlane(tid >> 6), lane = tid & 63, wr = wid >> 2, wc = wid & 3, fr = lane & 15, fq = lane >> 4;
    const int K = g.K, nt = K / BK;
    unsigned voffA[2], voffB[2];
#pragma unroll
    for (int i = 0; i < 2; ++i) { int R, C; stage_rc(tid * 16 + i * 8192, R, C); const int Rb = Epi::PERM ? ((R & ~31) + perm32(R & 31)) : R;
        voffA[i] = (unsigned)(R * K + C) * 2u; voffB[i] = (unsigned)(Rb * K + C) * 2u; }
    const size_t kstep = (size_t)(BK * 2);
    const size_t hstep = (size_t)HALF * K * 2;
    const size_t tstep = 2 * hstep;
    const unsigned ldsw = (unsigned)wid * 1024u;
    const int aoff = lds_byte(wr * 64 + fr, fq * 8), boff = lds_byte(wc * 32 + fr, fq * 8);
#define PG8_SA(b, h) (((b) * 2 + (h)) * HTB)
#define PG8_SB(b, h) ((4 + (b) * 2 + (h)) * HTB)
#define PG8_STAGE(bufoff, gbase, voff) do { _Pragma("unroll") for (int _i = 0; _i < 2; ++_i) \
        __builtin_amdgcn_global_load_lds((const unsigned*)((const char*)(gbase) + (voff)[_i]), (PG8_LAS unsigned*)(lds + (bufoff) + ldsw + _i * 8192), 16, 0, 0); } while (0)
#define PG8_LDA(dst, b, h) do { _Pragma("unroll") for (int m = 0; m < 4; ++m) _Pragma("unroll") for (int k = 0; k < 2; ++k) dst[m][k] = *(const PG8_LAS bf16x8*)(lds + PG8_SA(b, h) + aoff + m * 2048 + k * 1024); } while (0)
#define PG8_LDB(dst, b, h) do { _Pragma("unroll") for (int n = 0; n < 2; ++n) _Pragma("unroll") for (int k = 0; k < 2; ++k) dst[n][k] = *(const PG8_LAS bf16x8*)(lds + PG8_SB(b, h) + boff + n * 2048 + k * 1024); } while (0)
#define PG8_MMA(ai, bj, At, Bt) do { __builtin_amdgcn_s_setprio(1); _Pragma("unroll") for (int m = 0; m < 4; ++m) _Pragma("unroll") for (int n = 0; n < 2; ++n) _Pragma("unroll") for (int k = 0; k < 2; ++k) \
        acc[ai][bj][m][n] = __builtin_amdgcn_mfma_f32_16x16x32_bf16(Bt[n][k], At[m][k], acc[ai][bj][m][n], 0, 0, 0); __builtin_amdgcn_s_setprio(0); } while (0)
#define PG8_WAIT_V(n) asm volatile("s_waitcnt vmcnt(" #n ")" ::: "memory")
#define PG8_WAIT_L(n) asm volatile("s_waitcnt lgkmcnt(" #n ")" ::: "memory")
#define PG8_BAR __builtin_amdgcn_s_barrier()
#define PG8_SCHED __builtin_amdgcn_sched_barrier(0)
    Unit cur, nxt; int ui = 0;
    if (!S.next(0, cur)) return;
    f32x4 acc[2][2][4][2];
#pragma unroll
    for (int a = 0; a < 2; ++a)
#pragma unroll
        for (int b = 0; b < 2; ++b)
#pragma unroll
            for (int m = 0; m < 4; ++m)
#pragma unroll
                for (int n = 0; n < 2; ++n) acc[a][b][m][n] = (f32x4){0.f, 0.f, 0.f, 0.f};
    bf16x8 At[4][2], B0[2][2], B1[2][2];
    const char* cA = (const char*)g.A + (size_t)cur.pm * tstep; const char* cB = (const char*)g.Bt + (size_t)cur.pn * tstep;
    S.a_ready(cur);
    if constexpr (SP2) {
        PG8_STAGE(PG8_SB(0, 0), cB, voffB); PG8_STAGE(PG8_SB(0, 1), cB + hstep, voffB); PG8_STAGE(PG8_SA(0, 0), cA, voffA); PG8_STAGE(PG8_SA(0, 1), cA + hstep, voffA);
        if (wr == 1) PG8_BAR;
        PG8_WAIT_V(2); PG8_BAR;
        PG8_STAGE(PG8_SB(1, 0), cB + kstep, voffB); PG8_STAGE(PG8_SA(1, 0), cA + kstep, voffA); PG8_STAGE(PG8_SB(1, 1), cB + hstep + kstep, voffB);
        PG8_WAIT_V(6); PG8_BAR;
    } else {
        PG8_STAGE(PG8_SB(0, 0), cB, voffB); PG8_STAGE(PG8_SA(0, 0), cA, voffA); PG8_STAGE(PG8_SB(0, 1), cB + hstep, voffB); PG8_STAGE(PG8_SA(0, 1), cA + hstep, voffA);
        if (wr == 1) PG8_BAR;
        PG8_WAIT_V(4); PG8_BAR;
        PG8_STAGE(PG8_SB(1, 0), cB + kstep, voffB); PG8_STAGE(PG8_SA(1, 0), cA + kstep, voffA); PG8_STAGE(PG8_SB(1, 1), cB + hstep + kstep, voffB);
        PG8_WAIT_V(6); PG8_BAR;
    }
    for (;;) {
        const bool has_next = S.next(ui + 1, nxt);
        const char* nA = has_next ? (const char*)g.A + (size_t)nxt.pm * tstep : cA; const char* nB = has_next ? (const char*)g.Bt + (size_t)nxt.pn * tstep : cB;
        for (int t = 0; t < nt; t += 2) {
            const bool last = (t == nt - 2);
            const char* a1 = cA + (size_t)(t + 1) * kstep;
            const char* a2 = last ? nA : cA + (size_t)(t + 2) * kstep; const char* b2 = last ? nB : cB + (size_t)(t + 2) * kstep;
            const char* a3 = a2 + kstep; const char* b3 = b2 + kstep;
            if (last && has_next) S.a_ready(nxt);
            if constexpr (SP2) {
            PG8_LDB(B0, 0, 0); PG8_LDB(B1, 0, 1); PG8_SCHED; PG8_LDA(At, 0, 0); PG8_STAGE(PG8_SA(1, 1), a1 + hstep, voffA);
            PG8_WAIT_V(8); PG8_WAIT_L(0); PG8_BAR; PG8_MMA(0, 0, At, B0); PG8_MMA(0, 1, At, B1); PG8_BAR; PG8_SCHED;
            PG8_LDA(At, 0, 1); PG8_STAGE(PG8_SB(0, 0), b2, voffB); PG8_STAGE(PG8_SB(0, 1), b2 + hstep, voffB); PG8_STAGE(PG8_SA(0, 0), a2, voffA);
            PG8_WAIT_V(8); PG8_WAIT_L(0); PG8_BAR; PG8_MMA(1, 0, At, B0); PG8_MMA(1, 1, At, B1); PG8_BAR; PG8_SCHED;
            PG8_LDB(B0, 1, 0); PG8_LDB(B1, 1, 1); PG8_SCHED; PG8_LDA(At, 1, 0); PG8_STAGE(PG8_SA(0, 1), a2 + hstep, voffA);
            PG8_WAIT_V(8); PG8_WAIT_L(0); PG8_BAR; PG8_MMA(0, 0, At, B0); PG8_MMA(0, 1, At, B1); PG8_BAR; PG8_SCHED;
            PG8_LDA(At, 1, 1); PG8_STAGE(PG8_SB(1, 0), b3, voffB); PG8_STAGE(PG8_SB(1, 1), b3 + hstep, voffB); PG8_STAGE(PG8_SA(1, 0), a3, voffA);
            PG8_WAIT_V(8); PG8_WAIT_L(0); PG8_BAR; PG8_MMA(1, 0, At, B0); PG8_MMA(1, 1, At, B1); PG8_BAR; PG8_SCHED;
            } else {
            PG8_LDB(B0, 0, 0); PG8_SCHED; PG8_LDA(At, 0, 0); PG8_STAGE(PG8_SA(1, 1), a1 + hstep, voffA);
            PG8_WAIT_L(8); PG8_BAR; PG8_WAIT_L(0); PG8_MMA(0, 0, At, B0); PG8_BAR; PG8_SCHED;
            PG8_LDB(B1, 0, 1); PG8_STAGE(PG8_SB(0, 0), b2, voffB);
            PG8_BAR; PG8_WAIT_L(0); PG8_MMA(0, 1, At, B1); PG8_BAR;
            PG8_LDA(At, 0, 1); PG8_STAGE(PG8_SA(0, 0), a2, voffA);
            PG8_BAR; PG8_WAIT_L(0); PG8_MMA(1, 0, At, B0); PG8_BAR; PG8_SCHED;
            PG8_STAGE(PG8_SB(0, 1), b2 + hstep, voffB);
            PG8_WAIT_V(6); PG8_BAR; PG8_MMA(1, 1, At, B1); PG8_BAR;
            PG8_LDB(B0, 1, 0); PG8_SCHED; PG8_LDA(At, 1, 0); PG8_STAGE(PG8_SA(0, 1), a2 + hstep, voffA);
            PG8_WAIT_L(8); PG8_BAR; PG8_WAIT_L(0); PG8_MMA(0, 0, At, B0); PG8_BAR; PG8_SCHED;
            PG8_LDB(B1, 1, 1); PG8_STAGE(PG8_SB(1, 0), b3, voffB);
            PG8_BAR; PG8_WAIT_L(0); PG8_MMA(0, 1, At, B1); PG8_BAR;
            PG8_LDA(At, 1, 1); PG8_STAGE(PG8_SA(1, 0), a3, voffA);
            PG8_BAR; PG8_WAIT_L(0); PG8_MMA(1, 0, At, B0); PG8_BAR; PG8_SCHED;
            PG8_STAGE(PG8_SB(1, 1), b3 + hstep, voffB);
            PG8_WAIT_V(6); PG8_BAR; PG8_MMA(1, 1, At, B1); PG8_BAR;
            }
            if constexpr (Epi::HOOK) E.hook(acc, cur, t + 2, wr, wc, fr, fq);
        }
        if constexpr (ALIGN_EPI) { if (wr == 0) PG8_BAR; }
        if constexpr (!Epi::AFTER_DRAIN) { E(acc, cur, wr, wc, fr, fq); S.done(cur); }
        if (!has_next) break;
#pragma unroll
        for (int a = 0; a < 2; ++a)
#pragma unroll
            for (int b = 0; b < 2; ++b)
#pragma unroll
                for (int m = 0; m < 4; ++m)
#pragma unroll
                    for (int n = 0; n < 2; ++n) acc[a][b][m][n] = (f32x4){0.f, 0.f, 0.f, 0.f};
        cur = nxt; cA = nA; cB = nB; ++ui;
        if constexpr (ALIGN_EPI) { if (wr == 1) PG8_BAR; }
    }
    PG8_WAIT_V(0);
    if constexpr (!ALIGN_EPI) { if (wr == 0) PG8_BAR; }
    PG8_BAR;
    if constexpr (Epi::AFTER_DRAIN) { E.fused(acc, cur, wr, wc, fr, fq, lds, wid, lane); S.done(cur); }
#undef PG8_SA
#undef PG8_SB
#undef PG8_STAGE
#undef PG8_LDA
#undef PG8_LDB
#undef PG8_MMA
#undef PG8_WAIT_V
#undef PG8_WAIT_L
#undef PG8_BAR
#undef PG8_SCHED
}
}

#define LAS __attribute__((address_space(3)))
typedef unsigned short bf16;
typedef float f32x4 __attribute__((ext_vector_type(4)));
typedef short bf16x8 __attribute__((ext_vector_type(8)));
typedef unsigned v4u __attribute__((ext_vector_type(4)));
typedef unsigned v2u __attribute__((ext_vector_type(2)));

constexpr int NWAVES = 8, NTHREADS = 512;
constexpr int M = 12288, MCTX = 8192, DM = 1024, DFF = 2816, DIN = 5632;
constexpr int LDS_BYTES = 147456;
constexpr float LN_EPS = 1e-5f, RMS_EPS = 1e-5f;
struct Params {
    const float* in[31];
    float* out; unsigned char* ws;
    int ph_lo, ph_hi;
};
typedef const __attribute__((address_space(4))) Params& KP;
enum { I_XP = 0, I_XS, I_CDK, I_CDV, I_CNK, I_CNV, I_C, I_CCTX, I_WMOD, I_BMOD, I_LNG, I_LNB, I_F1W1, I_F1W3, I_F1W2, I_F2W1, I_F2W3, I_F2W2, I_WIN, I_POOLW, I_POOLS, I_WPA, I_WPB, I_WPC,
       I_LQ1, I_LK1, I_LQ2, I_LK2, I_SUBG, I_RPB, I_WOUT };

__device__ __forceinline__ unsigned f2bf(float f) { unsigned u = __builtin_bit_cast(unsigned, f); return (u + 0x7fffu + ((u >> 16) & 1u)) >> 16; }
__device__ __forceinline__ unsigned pk2(float lo, float hi) { return f2bf(lo) | (f2bf(hi) << 16); }
__device__ __forceinline__ float bf2f(unsigned short h) { return __uint_as_float((unsigned)h << 16); }
__device__ __forceinline__ float wave_sum(float v) {
#pragma unroll
    for (int o = 1; o < 64; o <<= 1) v += __shfl_xor(v, o);
    return v;
}

__device__ __forceinline__ void transpose_item(const float* W, int N, int k0, int n0, bf16* dst, int dpitch, LAS float* scr, int lane) {
#pragma unroll 8
    for (int i = 0; i < 32; ++i) { const int kk = 2 * i + (lane >> 5); scr[kk * 33 + (lane & 31)] = W[(size_t)(k0 + kk) * N + n0 + (lane & 31)]; }
    asm volatile("s_waitcnt lgkmcnt(0)" ::: "memory");
    const int c = lane & 7;
#pragma unroll
    for (int j = 0; j < 4; ++j) { const int n = (lane >> 3) + 8 * j; const LAS float* s = scr + (8 * c) * 33 + n;
        v4u o; o.x = pk2(s[0 * 33], s[1 * 33]); o.y = pk2(s[2 * 33], s[3 * 33]); o.z = pk2(s[4 * 33], s[5 * 33]); o.w = pk2(s[6 * 33], s[7 * 33]);
        *(v4u*)(dst + (size_t)n * dpitch + 8 * c) = o; }
    asm volatile("s_waitcnt lgkmcnt(0)" ::: "memory");
}

__device__ __forceinline__ void prologue_phase(KP P, LAS unsigned char* lds, int tid, int lane, int wave) {
    unsigned char* ws = P.ws;
    {
        LAS float* sc = (LAS float*)lds;
        LAS float* red = (LAS float*)(lds + 12288);
        for (int i = tid; i < 3072; i += NTHREADS) { const int ci = i >> 10, k = i & 1023; const float v = ci == 0 ? P.in[I_CCTX][k] : P.in[I_C][(ci - 1) * 1024 + k]; sc[i] = v / (1.0f + __expf(-v)); }
        __syncthreads();
        float* MOD = (float*)(ws + WS_MOD);
        const int cq = tid & 15, kg = tid >> 4;
        for (int u = blockIdx.x; u < 288; u += gridDim.x) {
            const int l = u / 144, jg = u % 144;
            const float* wp = P.in[I_WMOD] + (size_t)l * 1024 * 9216 + jg * 64 + 4 * cq;
            f32x4 a0 = {0.f, 0.f, 0.f, 0.f}, a1 = a0, a2 = a0;
#pragma unroll 4
            for (int i = 0; i < 32; ++i) { const int k = kg + 32 * i; const f32x4 w = *(const f32x4*)(wp + (size_t)k * 9216); a0 += w * sc[k]; a1 += w * sc[1024 + k]; a2 += w * sc[2048 + k]; }
#pragma unroll
            for (int e = 0; e < 4; ++e) { red[(kg * 3 + 0) * 64 + 4 * cq + e] = a0[e]; red[(kg * 3 + 1) * 64 + 4 * cq + e] = a1[e]; red[(kg * 3 + 2) * 64 + 4 * cq + e] = a2[e]; }
            __syncthreads();
            if (tid < 192) { const int ci = tid >> 6, j = tid & 63; float s = 0.f;
                for (int g = 0; g < 32; ++g) s += red[(g * 3 + ci) * 64 + j];
                MOD[(size_t)(ci * 2 + l) * 9216 + jg * 64 + j] = s + P.in[I_BMOD][l * 9216 + jg * 64 + j]; }
            __syncthreads();
        }
    }
    if (blockIdx.x == 0) {
        float* rope = (float*)(ws + WS_ROPE);
        for (int i = tid; i < 1024; i += NTHREADS) { const int pos = i >> 4, f = i & 15; const float inv = powf(10000.0f, -(float)f / 16.0f); const float ang = (float)pos * inv; rope[pos * 32 + f] = cosf(ang); rope[pos * 32 + 16 + f] = sinf(ang); }
        if (wave < 2) { const int l = wave; const float d1 = wave_sum(P.in[I_LQ1][l * 64 + lane] * P.in[I_LK1][l * 64 + lane]), d2 = wave_sum(P.in[I_LQ2][l * 64 + lane] * P.in[I_LK2][l * 64 + lane]);
            const float lam_init = 0.8f - 0.6f * expf(-0.3f * (float)l);
            if (lane == 0) { float* LAM = (float*)(ws + WS_LAM); LAM[l * 2] = expf(d1) - expf(d2) + lam_init; LAM[l * 2 + 1] = 1.0f - lam_init; } }
    }
    {
        const int gt = blockIdx.x * NTHREADS + tid, NT = gridDim.x * NTHREADS;
        bf16* kld = (bf16*)(ws + WS_KC_LD); bf16* kln = (bf16*)(ws + WS_KC_LN);
        for (int i = gt; i < 1048576 / 4; i += NT) { const int e = 4 * i, d = e & 63, mp = (e >> 6) & 1, h = (e >> 7) & 3, key = (e >> 9) & 511, l = (e >> 18) & 1, bl = e >> 19;
            const f32x4 v = ((const f32x4*)P.in[I_CDK])[i]; v2u o; o.x = pk2(v[0], v[1]); o.y = pk2(v[2], v[3]);
            *(v2u*)(kld + ((size_t)(((l * 2 + bl) * 4 + h) * 2 + mp) * 2560 + 2048 + key) * 64 + d) = o; }
        for (int i = gt; i < 524288 / 4; i += NT) { const int e = 4 * i, d = e & 63, h = (e >> 6) & 3, key = (e >> 8) & 511, l = (e >> 17) & 1, bl = e >> 18;
            const f32x4 v = ((const f32x4*)P.in[I_CNK])[i]; v2u o; o.x = pk2(v[0], v[1]); o.y = pk2(v[2], v[3]);
            *(v2u*)(kln + ((size_t)((l * 2 + bl) * 4 + h) * 2560 + 2048 + key) * 64 + d) = o; }
        bf16* vld = (bf16*)(ws + WS_VT_LD); bf16* vln = (bf16*)(ws + WS_VT_LN);
        for (int i = gt; i < 1048576; i += NT) {
            const int key = i & 511, dv = (i >> 9) & 127, h = (i >> 16) & 3, bl = (i >> 18) & 1, l = i >> 19, kk = 2048 + key;
            const float v = P.in[I_CDV][((size_t)((bl * 2 + l) * 512 + key)) * 512 + h * 128 + dv];
            vld[(size_t)((l * 2 + bl) * 4 + h) * 128 * 2560 + ((size_t)(kk >> 5) * 128 + dv) * 32 + (kk & 31)] = (bf16)f2bf(v); }
        for (int i = gt; i < 524288; i += NT) {
            const int key = i & 511, dv = (i >> 9) & 63, h = (i >> 15) & 3, bl = (i >> 17) & 1, l = i >> 18, kk = 2048 + key;
            const float v = P.in[I_CNV][((size_t)((bl * 2 + l) * 512 + key)) * 256 + h * 64 + dv];
            vln[(size_t)((l * 2 + bl) * 4 + h) * 64 * 2560 + ((size_t)(kk >> 5) * 64 + dv) * 32 + (kk & 31)] = (bf16)f2bf(v); }
    }
    {
        LAS float* scr = (LAS float*)(lds + 40960 + wave * 8704);
        const int gw = blockIdx.x * NWAVES + wave, NGW = gridDim.x * NWAVES;
        for (int it = gw; it < 2 * 12288; it += NGW) {
            const int l = it / 12288; int r = it % 12288;
            bf16* wl = (bf16*)(ws + WS_W + (size_t)l * WL_SIZE);
            const float* src; int N, k0, n0; bf16* dst; int dp;
            if (r < 8448) {
                const int which = r / 1408, q = r % 1408; const int ffn = which / 3, mat = which % 3;
                if (mat < 2) { N = DFF; const int kb = q / 88, nb = q % 88; k0 = 64 * kb; n0 = 32 * nb;
                    src = P.in[(ffn ? I_F2W1 : I_F1W1) + mat] + (size_t)l * 1024 * DFF;
                    dst = (bf16*)((unsigned char*)wl + (ffn ? WL_W13B : WL_W13A)) + (size_t)((n0 >> 7) * 256 + (n0 & 127) + mat * 128) * 1024 + k0; dp = 1024; }
                else { N = 1024; const int kb = q / 32, nb = q % 32; k0 = 64 * kb; n0 = 32 * nb;
                    src = P.in[ffn ? I_F2W2 : I_F1W2] + (size_t)l * DFF * 1024;
                    dst = (bf16*)((unsigned char*)wl + (ffn ? WL_W2B : WL_W2A)) + (size_t)n0 * DFF + k0; dp = DFF; }
            } else { r -= 8448;
                if (r < 2816) { N = DIN; const int kb = r / 176, nb = r % 176; k0 = 64 * kb; n0 = 32 * nb; src = P.in[I_WIN] + (size_t)l * 1024 * DIN; dst = (bf16*)((unsigned char*)wl + WL_WIN) + (size_t)n0 * 1024 + k0; dp = 1024; }
                else { r -= 2816; N = 1024; const int kb = r / 32, nb = r % 32; n0 = 32 * nb; dp = 1024;
                    if (kb < 4) { k0 = 64 * kb; src = P.in[I_WPA] + (size_t)l * 256 * 1024; dst = (bf16*)((unsigned char*)wl + WL_WP) + (size_t)n0 * 1024 + k0; }
                    else if (kb < 12) { k0 = 64 * (kb - 4); src = P.in[I_WPB] + (size_t)l * 512 * 1024; dst = (bf16*)((unsigned char*)wl + WL_WP) + (size_t)n0 * 1024 + 256 + k0; }
                    else if (kb < 16) { k0 = 64 * (kb - 12); src = P.in[I_WPC] + (size_t)l * 256 * 1024; dst = (bf16*)((unsigned char*)wl + WL_WP) + (size_t)n0 * 1024 + 768 + k0; }
                    else { k0 = 64 * (kb - 16); src = P.in[I_WOUT] + (size_t)l * 1024 * 1024; dst = (bf16*)((unsigned char*)wl + WL_WOUT) + (size_t)n0 * 1024 + k0; } }
            }
            transpose_item(src, N, k0, n0, dst, dp, scr, lane);
        }
    }
}

__device__ __forceinline__ void ln_phase(KP P, int mode, int l, int i, int nl, int ni, int lane, int wave) {
    float* X = P.out; bf16* XM = (bf16*)(P.ws + WS_XM); const float* MOD = (const float*)(P.ws + WS_MOD);
    const int gw = blockIdx.x * NWAVES + wave, NGW = gridDim.x * NWAVES;
    for (int row = gw; row < M; row += NGW) {
        const int cond = row < MCTX ? 0 : 1 + ((row - MCTX) >> 11);
        const float* src = mode ? X + (size_t)row * DM : (row < MCTX ? P.in[I_XP] + (size_t)row * DM : P.in[I_XS] + (size_t)(row - MCTX) * DM);
        f32x4 v[4];
#pragma unroll
        for (int j = 0; j < 4; ++j) v[j] = ((const f32x4*)src)[lane + 64 * j];
        if (mode) {
            float s = 0.f;
#pragma unroll
            for (int j = 0; j < 4; ++j) s += (v[j][0] + v[j][1]) + (v[j][2] + v[j][3]);
            const float mean = wave_sum(s) * (1.0f / DM); float s2 = 0.f;
#pragma unroll
            for (int j = 0; j < 4; ++j) { v[j] = v[j] - mean; s2 += (v[j][0] * v[j][0] + v[j][1] * v[j][1]) + (v[j][2] * v[j][2] + v[j][3] * v[j][3]); }
            const float rstd = 1.0f / sqrtf(wave_sum(s2) * (1.0f / DM) + LN_EPS);
            const f32x4* g = (const f32x4*)(P.in[I_LNG] + (size_t)(l * 3 + i) * DM); const f32x4* b = (const f32x4*)(P.in[I_LNB] + (size_t)(l * 3 + i) * DM);
#pragma unroll
            for (int j = 0; j < 4; ++j) v[j] = v[j] * rstd * g[lane + 64 * j] + b[lane + 64 * j];
        }
#pragma unroll
        for (int j = 0; j < 4; ++j) ((f32x4*)(X + (size_t)row * DM))[lane + 64 * j] = v[j];
        if (ni >= 0) {
            const f32x4* sh = (const f32x4*)(MOD + (size_t)(cond * 2 + nl) * 9216 + (3 * ni) * DM); const f32x4* scl = (const f32x4*)(MOD + (size_t)(cond * 2 + nl) * 9216 + (3 * ni + 1) * DM);
#pragma unroll
            for (int j = 0; j < 4; ++j) { const f32x4 o = v[j] * (scl[lane + 64 * j] + 1.0f) + sh[lane + 64 * j]; v2u w; w.x = pk2(o[0], o[1]); w.y = pk2(o[2], o[3]);
                ((v2u*)(XM + (size_t)row * DM))[lane + 64 * j] = w; }
        }
    }
}

constexpr float kScaleLog2 = 0.125f * 1.44269504088896341f;
constexpr float kLog2e = 1.44269504088896341f;
template <int NMAP, int DV> struct AState { f32x4 o[NMAP][DV / 16]; float m[NMAP], l[NMAP]; };
__device__ __forceinline__ unsigned cvtpk(float lo, float hi) { unsigned r; asm volatile("v_cvt_pk_bf16_f32 %0, %1, %2" : "=v"(r) : "v"(lo), "v"(hi)); return r; }

template <int NMAP, int DV, bool NA>
__device__ __forceinline__ void chunk_core(AState<NMAP, DV>& st, const f32x4 (&s)[NMAP][2], const bf16x8 (&va)[DV / 16], int c, const float* rpb, int qr, int rs, int qcol, int cs, int fq) {
    bf16x8 pb[NMAP];
#pragma unroll
    for (int mp = 0; mp < NMAP; ++mp) {
        float sc[8];
#pragma unroll
        for (int t2 = 0; t2 < 2; ++t2)
#pragma unroll
            for (int r = 0; r < 4; ++r) {
                float v = s[mp][t2][r] * kScaleLog2;
                if (NA) { const int kk = c + 16 * t2 + 4 * fq + r, kc = kk & 63, dr = rs + (kk >> 6) - qr + 7; int dc = kc - qcol; dc = dc < -15 ? -15 : (dc > 15 ? 15 : dc);
                    const bool ok = kc >= cs && kc < cs + 16;
                    v = ok ? v + rpb[dr * 31 + dc + 15] * kLog2e : -1e30f; }
                sc[t2 * 4 + r] = v; }
        float mx = fmaxf(fmaxf(fmaxf(sc[0], sc[1]), fmaxf(sc[2], sc[3])), fmaxf(fmaxf(sc[4], sc[5]), fmaxf(sc[6], sc[7])));
        mx = fmaxf(mx, __shfl_xor(mx, 16)); mx = fmaxf(mx, __shfl_xor(mx, 32));
        const float mold = st.m[mp], mnew = fmaxf(mold, mx);
        if (__any(mnew > mold)) {
            const float corr = __builtin_amdgcn_exp2f(mold - mnew); st.m[mp] = mnew; st.l[mp] *= corr;
#pragma unroll
            for (int dt = 0; dt < DV / 16; ++dt) st.o[mp][dt] = st.o[mp][dt] * corr; }
        float p[8], rsum = 0.f;
#pragma unroll
        for (int e = 0; e < 8; ++e) { p[e] = __builtin_amdgcn_exp2f(sc[e] - mnew); rsum += p[e]; }
        st.l[mp] += rsum;
        v4u w; w.x = cvtpk(p[0], p[1]); w.y = cvtpk(p[2], p[3]); w.z = cvtpk(p[4], p[5]); w.w = cvtpk(p[6], p[7]);
        pb[mp] = __builtin_bit_cast(bf16x8, w);
    }
#pragma unroll
    for (int dt = 0; dt < DV / 16; ++dt)
#pragma unroll
        for (int mp = 0; mp < NMAP; ++mp) st.o[mp][dt] = __builtin_amdgcn_mfma_f32_16x16x32_bf16(va[dt], pb[mp], st.o[mp][dt], 0, 0, 0);
}

template <int NMAP, int DV, bool NA>
__device__ __forceinline__ void attn_seg(AState<NMAP, DV>& st, const bf16x8 (&qf)[NMAP][2], const bf16* kl, size_t kmap, int nkeys, const bf16* vl,
                                         const float* rpb, int qr, int rs, int qcol, int fq) {
    const int cs = qcol - 8 < 0 ? 0 : (qcol - 8 > 48 ? 48 : qcol - 8);
    for (int c = 0; c < nkeys; c += 32) {
        f32x4 s[NMAP][2];
#pragma unroll
        for (int mp = 0; mp < NMAP; ++mp)
#pragma unroll
            for (int t2 = 0; t2 < 2; ++t2) { const bf16* kp = kl + (size_t)(c + 16 * t2) * 64 + mp * kmap;
                const bf16x8 a0 = *(const bf16x8*)kp, a1 = *(const bf16x8*)(kp + 32);
                f32x4 z = {0.f, 0.f, 0.f, 0.f};
                z = __builtin_amdgcn_mfma_f32_16x16x32_bf16(a0, qf[mp][0], z, 0, 0, 0);
                s[mp][t2] = __builtin_amdgcn_mfma_f32_16x16x32_bf16(a1, qf[mp][1], z, 0, 0, 0); }
        bf16x8 va[DV / 16];
#pragma unroll
        for (int dt = 0; dt < DV / 16; ++dt) { const bf16* vp = vl + (size_t)c * DV + dt * 512;
            const v2u lo = *(const v2u*)vp, hi = *(const v2u*)(vp + 16); v4u w; w.x = lo.x; w.y = lo.y; w.z = hi.x; w.w = hi.y; va[dt] = __builtin_bit_cast(bf16x8, w); }
        chunk_core<NMAP, DV, NA>(st, s, va, c, rpb, qr, rs, qcol, cs, fq);
    }
}
template <int NMAP, int DV> __device__ __forceinline__ void astate_init(AState<NMAP, DV>& st) {
#pragma unroll
    for (int mp = 0; mp < NMAP; ++mp) { st.m[mp] = -1e30f; st.l[mp] = 0.f;
#pragma unroll
        for (int dt = 0; dt < DV / 16; ++dt) st.o[mp][dt] = (f32x4){0.f, 0.f, 0.f, 0.f}; }
}
__device__ __forceinline__ void load_q(bf16x8 (&q)[2], const bf16* qp) { q[0] = *(const bf16x8*)qp; q[1] = *(const bf16x8*)(qp + 32); }

__device__ __forceinline__ void diff_finalize(KP P, int l, AState<2, 128>& st, int qrow0, int h, int lane) {
    const int fr = lane & 15, fq = lane >> 4;
    float l0 = st.l[0], l1 = st.l[1];
    l0 += __shfl_xor(l0, 16); l0 += __shfl_xor(l0, 32); l1 += __shfl_xor(l1, 16); l1 += __shfl_xor(l1, 32);
    const float* LAM = (const float*)(P.ws + WS_LAM);
    const float i0 = 1.0f / l0, i1 = LAM[l * 2] / l1, post = LAM[l * 2 + 1];
    float ss = 0.f;
#pragma unroll
    for (int dt = 0; dt < 8; ++dt) { const f32x4 v = st.o[0][dt] * i0 - st.o[1][dt] * i1; st.o[0][dt] = v; ss += (v[0] * v[0] + v[1] * v[1]) + (v[2] * v[2] + v[3] * v[3]); }
    ss += __shfl_xor(ss, 16); ss += __shfl_xor(ss, 32);
    const float rms = 1.0f / sqrtf(ss * (1.0f / 128.0f) + RMS_EPS) * post;
    bf16* yp = (bf16*)(P.ws + WS_XM) + (size_t)(qrow0 + fr) * DM + 256 + h * 128 + 4 * fq;
    const float* g = P.in[I_SUBG] + l * 128 + 4 * fq;
#pragma unroll
    for (int dt = 0; dt < 8; ++dt) { const f32x4 v = st.o[0][dt] * rms * *(const f32x4*)(g + 16 * dt); v2u w; w.x = cvtpk(v[0], v[1]); w.y = cvtpk(v[2], v[3]); *(v2u*)(yp + 16 * dt) = w; }
}

constexpr int LD_SUB = 19456, LD_BUF = 2 * LD_SUB, LD_VOFF = 9216, LD_STEPS = 40;
__device__ __forceinline__ void ld_unit(KP P, int l, const bf16* Z, int qrow0w, int h, const bf16* kc, const bf16* vt, LAS unsigned char* lds, int tid, int lane, int wave) {
    const int fr = lane & 15, fq = lane >> 4, sh = wave >> 2;
    bf16x8 qf[2][2];
    const bf16* qp = Z + (size_t)(qrow0w + fr) * ZP + 256 + h * 128 + 8 * fq;
    load_q(qf[0], qp); load_q(qf[1], qp + 64);
    AState<2, 128> st; astate_init(st);
    const int kkey = (tid >> 3) & 31, kpart = tid & 7, kmp = (tid >> 8) & 1;
    const bf16* kg = kc + ((size_t)kmp * 2560 + kkey) * 64 + kpart * 8;
    const unsigned kl_off = kmp * 4608 + kkey * 144 + kpart * 16;
    const int vdv = (tid >> 2) & 127, vpart = tid & 3;
    const bf16* vg = vt + vdv * 32 + vpart * 8;
    const unsigned vl_off = LD_VOFF + vdv * 80 + vpart * 16;
    v4u rk[2], rv[2];
#pragma unroll
    for (int i = 0; i < 2; ++i) { rk[i] = *(const v4u*)(kg + (size_t)(i * 1280) * 64); rv[i] = *(const v4u*)(vg + (size_t)(i * 40) * 4096); }
#pragma unroll
    for (int i = 0; i < 2; ++i) { *(LAS v4u*)(lds + i * LD_SUB + kl_off) = rk[i]; *(LAS v4u*)(lds + i * LD_SUB + vl_off) = rv[i]; }
    __syncthreads();
    const unsigned kr_off = sh * LD_SUB + fr * 144 + fq * 16, vr_off = sh * LD_SUB + LD_VOFF + fr * 80 + fq * 8;
    for (int sidx = 0; sidx < LD_STEPS; ++sidx) {
        const bool more = sidx + 1 < LD_STEPS;
        if (more) {
#pragma unroll
            for (int i = 0; i < 2; ++i) { rk[i] = *(const v4u*)(kg + (size_t)(i * 1280 + (sidx + 1) * 32) * 64); rv[i] = *(const v4u*)(vg + (size_t)(i * 40 + sidx + 1) * 4096); } }
        LAS unsigned char* cur = lds + (sidx & 1) * LD_BUF;
        f32x4 s[2][2];
#pragma unroll
        for (int mp = 0; mp < 2; ++mp)
#pragma unroll
            for (int t2 = 0; t2 < 2; ++t2) { const LAS unsigned char* kp = cur + kr_off + mp * 4608 + t2 * (16 * 144);
                const bf16x8 a0 = *(const LAS bf16x8*)kp, a1 = *(const LAS bf16x8*)(kp + 64);
                f32x4 z = {0.f, 0.f, 0.f, 0.f};
                z = __builtin_amdgcn_mfma_f32_16x16x32_bf16(a0, qf[mp][0], z, 0, 0, 0);
                s[mp][t2] = __builtin_amdgcn_mfma_f32_16x16x32_bf16(a1, qf[mp][1], z, 0, 0, 0); }
        bf16x8 va[8];
#pragma unroll
        for (int dt = 0; dt < 8; ++dt) { const LAS unsigned char* vp = cur + vr_off + dt * (16 * 80);
            const v2u lo = *(const LAS v2u*)vp, hi = *(const LAS v2u*)(vp + 32); v4u w; w.x = lo.x; w.y = lo.y; w.z = hi.x; w.w = hi.y; va[dt] = __builtin_bit_cast(bf16x8, w); }
        chunk_core<2, 128, false>(st, s, va, 0, nullptr, 0, 0, 0, 0, fq);
        if (more) { LAS unsigned char* nxt = lds + ((sidx + 1) & 1) * LD_BUF;
#pragma unroll
            for (int i = 0; i < 2; ++i) { *(LAS v4u*)(nxt + i * LD_SUB + kl_off) = rk[i]; *(LAS v4u*)(nxt + i * LD_SUB + vl_off) = rv[i]; } }
        __syncthreads();
    }
    LAS float* xs = (LAS float*)lds;
    if (sh == 1) { LAS float* x = xs + (size_t)(wave - 4) * 68 * 64 + lane;
        x[0] = st.m[0]; x[64] = st.m[1]; x[128] = st.l[0]; x[192] = st.l[1];
#pragma unroll
        for (int mp = 0; mp < 2; ++mp)
#pragma unroll
            for (int dt = 0; dt < 8; ++dt)
#pragma unroll
                for (int e = 0; e < 4; ++e) x[(4 + (mp * 8 + dt) * 4 + e) * 64] = st.o[mp][dt][e]; }
    __syncthreads();
    if (sh == 0) { const LAS float* x = xs + (size_t)wave * 68 * 64 + lane;
#pragma unroll
        for (int mp = 0; mp < 2; ++mp) { const float mb = x[mp * 64], lb = x[(2 + mp) * 64]; const float m = fmaxf(st.m[mp], mb);
            const float ca = __builtin_amdgcn_exp2f(st.m[mp] - m), cb = __builtin_amdgcn_exp2f(mb - m);
            st.l[mp] = st.l[mp] * ca + lb * cb;
#pragma unroll
            for (int dt = 0; dt < 8; ++dt)
#pragma unroll
                for (int e = 0; e < 4; ++e) st.o[mp][dt][e] = st.o[mp][dt][e] * ca + x[(4 + (mp * 8 + dt) * 4 + e) * 64] * cb; }
        diff_finalize(P, l, st, qrow0w, h, lane); }
    __syncthreads();
}

__device__ __forceinline__ void diff_unit(KP P, int l, const bf16* Z, int qrow0, int h, const bf16* kc, const bf16* vt, int nk, int lane) {
    const int fr = lane & 15, fq = lane >> 4;
    bf16x8 qf[2][2];
    const bf16* qp = Z + (size_t)(qrow0 + fr) * ZP + 256 + h * 128 + 8 * fq;
    load_q(qf[0], qp); load_q(qf[1], qp + 64);
    AState<2, 128> st; astate_init(st);
    attn_seg<2, 128, false>(st, qf, kc + fr * 64 + 8 * fq, (size_t)nk * 64, nk, vt + fr * 32 + 4 * fq, nullptr, 0, 0, 0, fq);
    diff_finalize(P, l, st, qrow0, h, lane);
}

template <bool NA>
__device__ __forceinline__ void na_unit(KP P, const bf16* Z, int qrow0, int h, const bf16* kc, const bf16* vt, int kA0, int nA, int kB0, int nB, const float* rpb, int qr, int rs, int w0, int lane) {
    const int fr = lane & 15, fq = lane >> 4;
    bf16x8 qf[1][2];
    load_q(qf[0], Z + (size_t)(qrow0 + fr) * ZP + 768 + h * 64 + 8 * fq);
    AState<1, 64> st; astate_init(st);
    attn_seg<1, 64, NA>(st, qf, kc + (size_t)(kA0 + fr) * 64 + 8 * fq, 0, nA, vt + (size_t)kA0 * 64 + fr * 32 + 4 * fq, rpb, qr, rs, w0 + fr, fq);
    if (nB > 0) attn_seg<1, 64, false>(st, qf, kc + (size_t)(kB0 + fr) * 64 + 8 * fq, 0, nB, vt + (size_t)kB0 * 64 + fr * 32 + 4 * fq, nullptr, 0, 0, 0, fq);
    float l0 = st.l[0]; l0 += __shfl_xor(l0, 16); l0 += __shfl_xor(l0, 32);
    const float i0 = 1.0f / l0;
    bf16* yp = (bf16*)(P.ws + WS_XM) + (size_t)(qrow0 + fr) * DM + 768 + h * 64 + 4 * fq;
#pragma unroll
    for (int dt = 0; dt < 4; ++dt) { const f32x4 v = st.o[0][dt] * i0; v2u w; w.x = cvtpk(v[0], v[1]); w.y = cvtpk(v[2], v[3]); *(v2u*)(yp + 16 * dt) = w; }
}

__device__ __forceinline__ void pool_unit(KP P, int l, const bf16* Z, int tok0, LAS unsigned char* lds, int tid) {
    LAS bf16* A = (LAS bf16*)lds;
    LAS float* PP = (LAS float*)(lds + 40960);
    const bool ctx = tok0 < MCTX; const int n = ctx ? 256 : 64; const int seg0 = ctx ? (tok0 & ~255) : tok0; const int t0 = tok0 - seg0;
    for (int i = tid; i < 80 * 32; i += NTHREADS) { const int rr = i >> 5, ch = i & 31; const int t = t0 - 8 + rr; v4u v = {0u, 0u, 0u, 0u};
        if (t >= 0 && t < n) v = *(const v4u*)(Z + (size_t)(seg0 + t) * ZP + 8 * ch);
        *(LAS v4u*)(A + rr * 256 + 8 * ch) = v; }
    __syncthreads();
    { const int c = tid & 255, half = tid >> 8, g = c >> 6, hw = 1 << g;
        for (int i = half * 32; i < half * 32 + 32; ++i) { const int t = t0 + i; const int lo = t - hw < 0 ? 0 : t - hw, hi = t + hw > n ? n : t + hw; float s = 0.f;
            for (int tt = lo; tt < hi; ++tt) s += bf2f(A[(tt - t0 + 8) * 256 + c]);
            PP[i * 256 + c] = s / (float)(hi - lo) - bf2f(A[(i + 8) * 256 + c]); } }
    __syncthreads();
    { const int gd = tid & 255, half = tid >> 8, g = gd >> 6, d = gd & 63;
        const float* w = P.in[I_POOLW] + (size_t)((l * 4 + g) * 64) * 64 + d;
        float acc[32];
#pragma unroll
        for (int i = 0; i < 32; ++i) acc[i] = 0.f;
        for (int c = 0; c < 64; c += 4) { const float w0 = w[(c + 0) * 64], w1 = w[(c + 1) * 64], w2 = w[(c + 2) * 64], w3 = w[(c + 3) * 64];
#pragma unroll
            for (int i = 0; i < 32; ++i) { const f32x4 pv = *(const LAS f32x4*)(PP + (half * 32 + i) * 256 + g * 64 + c); acc[i] += (pv[0] * w0 + pv[1] * w1) + (pv[2] * w2 + pv[3] * w3); } }
        const float scl = P.in[I_POOLS][l * 256 + gd];
        bf16* yp = (bf16*)(P.ws + WS_XM) + (size_t)(tok0 + half * 32) * DM + gd;
#pragma unroll
        for (int i = 0; i < 32; ++i) yp[(size_t)i * DM] = (bf16)f2bf(acc[i] * scl);
    }
    __syncthreads();
}

__device__ __forceinline__ void att_phase(KP P, int l, LAS unsigned char* lds, int tid, int lane, int wave) {
    const bf16* Z = (const bf16*)(P.ws + WS_UZ);
    for (int u = blockIdx.x; u < 1088; u += gridDim.x) {
        if (u < 256) {
            const int bl = u >> 7, h = (u >> 5) & 3, qb = u & 31; const int row0 = MCTX + bl * 2048; const int hh = (l * 2 + bl) * 4 + h;
            ld_unit(P, l, Z, row0 + qb * 64 + (wave & 3) * 16, h, (const bf16*)(P.ws + WS_KC_LD) + (size_t)hh * 2 * 2560 * 64, (const bf16*)(P.ws + WS_VT_LD) + (size_t)hh * 128 * 2560, lds, tid, lane, wave);
        } else if (u < 512) {
            const int v = u - 256, b = v >> 3, h = (v >> 1) & 3, qb = v & 1; const int row0 = b * 256; const int hh = b * 4 + h;
            diff_unit(P, l, Z, row0 + qb * 128 + wave * 16, h, (const bf16*)(P.ws + WS_KC_CD) + (size_t)hh * 2 * 256 * 64, (const bf16*)(P.ws + WS_VT_CD) + (size_t)hh * 128 * 256, 256, lane);
        } else if (u < 640) {
            const int v = u - 512, bl = v >> 6, h = (v >> 4) & 3, rb = v & 15; const int row0 = MCTX + bl * 2048; const int hh = (l * 2 + bl) * 4 + h;
            const int qr = 2 * rb + (wave >> 2), w0 = (wave & 3) * 16; const int rs = qr - 4 < 0 ? 0 : (qr - 4 > 24 ? 24 : qr - 4);
            na_unit<true>(P, Z, row0 + qr * 64 + w0, h, (const bf16*)(P.ws + WS_KC_LN) + (size_t)hh * 2560 * 64, (const bf16*)(P.ws + WS_VT_LN) + (size_t)hh * 64 * 2560, rs * 64, 512, 2048, 512,
                          P.in[I_RPB] + (size_t)(l * 4 + h) * 465, qr, rs, w0, lane);
        } else if (u < 896) {
            const int v = u - 640, b = v >> 3, h = (v >> 1) & 3, qb = v & 1; const int row0 = b * 256; const int hh = b * 4 + h;
            na_unit<false>(P, Z, row0 + qb * 128 + wave * 16, h, (const bf16*)(P.ws + WS_KC_CN) + (size_t)hh * 256 * 64, (const bf16*)(P.ws + WS_VT_CN) + (size_t)hh * 64 * 256, 0, 256, 0, 0, nullptr, 0, 0, 0, lane);
        } else {
            pool_unit(P, l, Z, (u - 896) * 64, lds, tid);
        }
    }
}

typedef __attribute__((address_space(1))) unsigned gu32;
#define XB_TMO      128
#define XB_XCNT(j)  (256  + 64 * (j))
#define XB_XSUB(j)  (1280 + 64 * (j))
#define XB_XGEN(j)  (2304 + 64 * (j))
#define XB_TOP      3328
#define XB_TOPGEN   3392
#define XCD_BAR_WORDS 3456
#define XB_SPIN_CAP (1u << 18)

__device__ __forceinline__ unsigned xb_ld(unsigned* p)              { return __hip_atomic_load(p, __ATOMIC_RELAXED, __HIP_MEMORY_SCOPE_AGENT); }
__device__ __forceinline__ unsigned xb_add(unsigned* p, unsigned v) { return __hip_atomic_fetch_add(p, v, __ATOMIC_RELAXED, __HIP_MEMORY_SCOPE_AGENT); }
__device__ __forceinline__ unsigned xb_xcc_id() { return (unsigned)__builtin_amdgcn_s_getreg((3 << 11) | 20) & 0xFu; }
#define XB_SPIN(cond, bar) do { unsigned _sp = 0; while (cond) { __builtin_amdgcn_s_sleep(1); \
    if ((++_sp & 255u) == 0u) { if (xb_ld(&(bar)[XB_TMO])) break; if (_sp > XB_SPIN_CAP) { atomicAdd(&(bar)[XB_TMO], 1u); break; } } } } while (0)

struct XcdBarrier {
    unsigned* bar; unsigned x;
    volatile LAS unsigned* st;
};

__device__ __forceinline__ XcdBarrier xcd_barrier_post(unsigned* bar, volatile LAS unsigned* st) {
    XcdBarrier b; b.bar = bar; b.x = xb_xcc_id(); b.st = st;
    if (threadIdx.x == 0) (void)xb_add(&bar[XB_XCNT(b.x)], 1u);
    return b;
}
__device__ __forceinline__ void xcd_barrier_complete(unsigned* bar, unsigned x, unsigned& nloc, unsigned& nx) {
    const unsigned G = gridDim.x * gridDim.y * gridDim.z;
    unsigned sum, cnt, mine, sp = 0u;
    for (;;) {
        sum = 0u; cnt = 0u; mine = 0u;
#pragma unroll
        for (unsigned j = 0; j < 16; ++j) { const unsigned c = xb_ld(&bar[XB_XCNT(j)]); sum += c; cnt += (c > 0u) ? 1u : 0u; mine = (j == x) ? c : mine; }
        if (sum == G) break;
        __builtin_amdgcn_s_sleep(1);
        if ((++sp & 255u) == 0u) { if (xb_ld(&bar[XB_TMO])) break; if (sp > XB_SPIN_CAP) { atomicAdd(&bar[XB_TMO], 1u); break; } }
    }
    nloc = mine > 0u ? mine : 1u; nx = cnt > 0u ? cnt : 1u;
}

__device__ __forceinline__ void xcd_barrier(const XcdBarrier& b) {
    asm volatile("s_waitcnt vmcnt(0)" ::: "memory");
    __syncthreads();
    if (threadIdx.x == 0) {
        unsigned* bar = b.bar;
        __builtin_amdgcn_s_waitcnt(0);
        unsigned nloc = b.st[0], nx = b.st[1];
        if (nloc == 0u) { xcd_barrier_complete(bar, b.x, nloc, nx); b.st[0] = nloc; b.st[1] = nx; }
        const unsigned old = xb_add(&bar[XB_XSUB(b.x)], 1u);
        const unsigned gen = old / nloc;
        if (old + 1u == (gen + 1u) * nloc) {
            __builtin_amdgcn_fence(__ATOMIC_RELEASE, "agent");
            asm volatile("s_waitcnt vmcnt(0)" ::: "memory");
            const unsigned og = xb_add(&bar[XB_TOP], 1u);
            const unsigned tg = og / nx;
            if (og + 1u == (tg + 1u) * nx) xb_add(&bar[XB_TOPGEN], 1u);
            else XB_SPIN(xb_ld(&bar[XB_TOPGEN]) == tg, bar);
            __builtin_amdgcn_fence(__ATOMIC_ACQUIRE, "agent");
            xb_add(&bar[XB_XGEN(b.x)], 1u);
            asm volatile("s_waitcnt vmcnt(0)" ::: "memory");
        } else {
            XB_SPIN(xb_ld(&bar[XB_XGEN(b.x)]) == gen, bar);
            __builtin_amdgcn_fence(__ATOMIC_ACQUIRE, "agent");
            asm volatile("s_waitcnt vmcnt(0)" ::: "memory");
        }
    }
    __syncthreads();
}

constexpr int N_PHASES = 24;
__global__ void __launch_bounds__(NTHREADS, 2) fwd_kernel(Params P0) {
    extern __shared__ __attribute__((aligned(16))) unsigned char lds_raw[];
    LAS unsigned char* lds = (LAS unsigned char*)lds_raw;
    cg::grid_group grid = cg::this_grid();
    if (threadIdx.x < 32) ((LAS unsigned*)(lds + 131072 + 320))[threadIdx.x] = 0u;
    __syncthreads();
    const XcdBarrier bar = xcd_barrier_post((unsigned*)P0.ws, (volatile LAS unsigned*)(lds + 131072 + 320) + 8);
    const int ph_lo = P0.ph_lo, ph_hi = P0.ph_hi;
    for (int ph = ph_lo; ph < ph_hi; ++ph) {
        const __attribute__((address_space(4))) Params* kp = (const __attribute__((address_space(4))) Params*)__builtin_amdgcn_kernarg_segment_ptr();
        asm volatile("" : "+s"(kp));
        KP P = *kp;
        unsigned char* ws = P.ws;
        int tid = threadIdx.x; asm volatile("" : "+v"(tid));
        const int lane = tid & 63, wave = __builtin_amdgcn_readfirstlane(tid >> 6);
#ifndef NO_PRO
        if (ph == 0) prologue_phase(P, lds, tid, lane, wave);
#else
        if (ph == 0) {}
#endif
        else if (ph == 1) ln_phase(P, 0, 0, 0, 0, 0, lane, wave);
        else {
            const int q = ph - 2, l = q / 11, s = q % 11;
            unsigned char* wl = ws + WS_W + (size_t)l * WL_SIZE;
            if (s == 0 || s == 8) {
                pg8::Gemm g{(const pg8::bf16_t*)(ws + WS_XM), (const pg8::bf16_t*)(wl + (s == 0 ? WL_W13A : WL_W13B)), M, DIN, DM}; pg8::StaticOrder S; S.init(M, DIN, gridDim.x, blockIdx.x);
                pg8::EpiSwiglu E{(pg8::bf16_t*)(ws + WS_UZ), DFF};
#ifndef NO_G1
                pg8::gemm_phase<pg8::EpiSwiglu, pg8::StaticOrder, true, true>(lds, g, S, E, tid);
#endif
            } else if (s == 1 || s == 6 || s == 9) {
                const pg8::bf16_t* A = (const pg8::bf16_t*)(ws + (s == 6 ? WS_MIX : WS_UZ)); const pg8::bf16_t* B = (const pg8::bf16_t*)(wl + (s == 1 ? WL_W2A : (s == 6 ? WL_WOUT : WL_W2B)));
                pg8::Gemm g{A, B, M, DM, s == 6 ? DM : DFF}; pg8::StaticOrder S; S.init(M, DM, gridDim.x, blockIdx.x);
                pg8::EpiResid E{P.out, (const float*)(ws + WS_MOD), l, s == 1 ? 2 : (s == 6 ? 5 : 8), s == 6 ? 1.0f : 0.5f};
#ifndef NO_G2
                pg8::gemm_phase<pg8::EpiResid, pg8::StaticOrder, true, true>(lds, g, S, E, tid);
#endif
            } else if (s == 2 || s == 7 || s == 10) {
                const int i = s == 2 ? 0 : (s == 7 ? 1 : 2);
                int nl = l, ni = i + 1; if (i == 2) { nl = l + 1; ni = nl < 2 ? 0 : -1; }
                ln_phase(P, 1, l, i, nl, ni, lane, wave);
            } else if (s == 3) {
                pg8::Gemm g{(const pg8::bf16_t*)(ws + WS_XM), (const pg8::bf16_t*)(wl + WL_WIN), M, DIN, DM}; pg8::StaticOrder S; S.init(M, DIN, gridDim.x, blockIdx.x);
                pg8::EpiZ E{ws, P.out, l};
#ifndef NO_G3
                pg8::gemm_phase<pg8::EpiZ, pg8::StaticOrder, true, true>(lds, g, S, E, tid);
#endif
            } else if (s == 4) {
#ifndef NO_ATT
                att_phase(P, l, lds, tid, lane, wave);
#if PROBE_ATT
                __syncthreads(); att_phase(P, l, lds, tid, lane, wave);
#endif
#endif
            } else {
                pg8::Gemm g{(const pg8::bf16_t*)(ws + WS_XM), (const pg8::bf16_t*)(wl + WL_WP), M, DM, DM}; pg8::StaticOrder S; S.init(M, DM, gridDim.x, blockIdx.x);
                pg8::EpiMerge E{(const pg8::bf16_t*)(ws + WS_UZ), (pg8::bf16_t*)(ws + WS_MIX)};
#ifndef NO_G4
                pg8::gemm_phase<pg8::EpiMerge, pg8::StaticOrder, true, true>(lds, g, S, E, tid);
#endif
            }
        }
        if (ph + 1 < ph_hi) { if (ph == 0) grid.sync(); else xcd_barrier(bar); }
#if PROBE_SYNC
        if (ph + 1 < ph_hi) xcd_barrier(bar);
#endif
    }
}

#ifndef MK_PER_PHASE
#define MK_PER_PHASE 0
#endif
extern "C" void kernel_launch(void* const* d_in, const int* in_sizes, int n_in, void* d_out, int out_size, void* d_ws, size_t ws_size, hipStream_t stream) {
    static int grid = 0;
    if (grid == 0) {
        if (n_in != 31 || ws_size < WS_END) { fprintf(stderr, "kernel_launch: need 31 inputs and %zu bytes of workspace (got %d, %zu)\n", (size_t)WS_END, n_in, ws_size); grid = -1; return; }
        int dev = 0, cus = 0, per_cu = 0;
        hipGetDevice(&dev); hipDeviceGetAttribute(&cus, hipDeviceAttributeMultiprocessorCount, dev);
        if (hipFuncSetAttribute((const void*)fwd_kernel, hipFuncAttributeMaxDynamicSharedMemorySize, LDS_BYTES) != hipSuccess) { fprintf(stderr, "kernel_launch: hipFuncSetAttribute failed\n"); grid = -1; return; }
        if (hipOccupancyMaxActiveBlocksPerMultiprocessor(&per_cu, (const void*)fwd_kernel, NTHREADS, LDS_BYTES) != hipSuccess || per_cu < 1) { fprintf(stderr, "kernel_launch: occupancy query says %d\n", per_cu); per_cu = 1; }
        (void)hipGetLastError();
        grid = cus * 1;
        fprintf(stderr, "kernel_launch: grid %d (cus %d, per_cu %d)\n", grid, cus, per_cu);
    }
    if (grid < 0) return;
    if (hipMemsetAsync(d_ws, 0, 65536, stream) != hipSuccess) { fprintf(stderr, "kernel_launch: memset failed\n"); return; }
    Params p{};
    for (int i = 0; i < 31; ++i) p.in[i] = (const float*)d_in[i];
    p.out = (float*)d_out; p.ws = (unsigned char*)d_ws;
#if MK_PER_PHASE
    for (int ph = 0; ph < N_PHASES; ++ph) { p.ph_lo = ph; p.ph_hi = ph + 1; hipLaunchKernelGGL(fwd_kernel, dim3(grid), dim3(NTHREADS), LDS_BYTES, stream, p); }
#else
    p.ph_lo = 0; p.ph_hi = N_PHASES;
    void* args[] = {&p};
    const hipError_t e = hipLaunchCooperativeKernel((const void*)fwd_kernel, dim3(grid), dim3(NTHREADS), args, LDS_BYTES, stream);
    if (e != hipSuccess) fprintf(stderr, "kernel_launch: cooperative launch failed: %s (grid %d)\n", hipGetErrorString(e), grid);
#endif
}
```
